# Optimizing an MI355X kernel written in HIP

```python
import math
import jax
import jax.numpy as jnp
from jax import lax
import numpy as np

D_MODEL = 2048
BATCH = 8
SEQ = 2048
DEPTH = 2

GRID_W = 64
CTX_LEN = 256
EPS = 1e-6
N_MOD = 9

FFN_HIDDEN = 5632

MLA_HEADS = D_MODEL // 256
MLA_NOPE = 128
MLA_ROPE = 64
MLA_V = 128
MLA_Q_LORA = D_MODEL // 4
MLA_KV_LORA = D_MODEL // 8
MLA_WIDTH = MLA_HEADS * MLA_V
ROPE_BASE = 10000.0
ATTN_BLOCK = 128

HY_WIDTH = D_MODEL // 4
HY_ORDER = 2
HY_SHORT = 3
HY_EMB = 33
HY_FFN = 64
HY_SIN_FREQ = 1.0
HY_MIN_DECAY = math.log(1e-2) / 1.5
HY_MAX_DECAY = math.log(1e-2) / 0.3
HY_WINDOW_SHIFT = 0.05

RET_HEADS = D_MODEL // 512
RET_DK = 64
RET_DV = 128
RET_WIDTH = RET_HEADS * RET_DV
RET_CHUNK = 128

COL_SIZES = (MLA_KV_LORA, MLA_ROPE, RET_HEADS * RET_DK, RET_WIDTH,
             MLA_Q_LORA, RET_HEADS * RET_DK, RET_WIDTH, (HY_ORDER + 1) * HY_WIDTH)
N_KV_COLS = sum(COL_SIZES[:4])
N_IN = sum(COL_SIZES)

kernel_name = 'hybrid_mla_hyena_retention_dit_block'


def split_cols(z, sizes):
    return jnp.split(z, [int(s) for s in np.cumsum(sizes)[:-1]], axis=-1)


def rms_norm(x, gain=None):
    xf = x.astype(jnp.float32)
    y = xf * lax.rsqrt(jnp.mean(xf * xf, axis=-1, keepdims=True) + EPS)
    if gain is not None:
        y = y * gain.astype(jnp.float32)
    return y.astype(x.dtype)


def modulate(x, shift, scale):
    return rms_norm(x) * (1 + scale) + shift


def modulation(cond, w, b):
    m = jax.nn.silu(cond) @ w + b
    m = m.reshape((-1, 1, m.shape[-1]))
    return jnp.split(m, N_MOD, axis=-1)


def swiglu(h, w_gate, w_up, w_down):
    return (jax.nn.silu(h @ w_gate) * (h @ w_up)) @ w_down


def axial_rope_tables(rows, dtype):
    n_freq = MLA_ROPE // 4
    inv_freq = ROPE_BASE ** (-jnp.arange(n_freq, dtype=jnp.float32) / n_freq)
    row = jnp.repeat(jnp.arange(rows), GRID_W).astype(jnp.float32)
    col = jnp.tile(jnp.arange(GRID_W), rows).astype(jnp.float32)
    tabs = []
    for pos in (row, col):
        ang = pos[:, None] * inv_freq[None, :]
        tabs += [jnp.cos(ang)[None, :, None, :].astype(dtype), jnp.sin(ang)[None, :, None, :].astype(dtype)]
    return tuple(tabs)


def rotate(x, cos, sin):
    x1, x2 = jnp.split(x, 2, axis=-1)
    return jnp.concatenate([x1 * cos - x2 * sin, x1 * sin + x2 * cos], axis=-1)


def apply_axial_rope(x, rope):
    cos_r, sin_r, cos_c, sin_c = rope
    x_row, x_col = jnp.split(x, 2, axis=-1)
    return jnp.concatenate([rotate(x_row, cos_r, sin_r), rotate(x_col, cos_c, sin_c)], axis=-1)


def mla_queries(q_lat, p, rope):
    b, n, _ = q_lat.shape
    q = (rms_norm(q_lat, p['mla_q_norm']) @ p['mla_wuq']).reshape(b, n, MLA_HEADS, MLA_NOPE + MLA_ROPE)
    q_nope = rms_norm(q[..., :MLA_NOPE], p['mla_qn_nope'])
    q_rope = rms_norm(q[..., MLA_NOPE:], p['mla_qn_rope'])
    if rope is not None:
        q_rope = apply_axial_rope(q_rope, rope)
    return jnp.concatenate([q_nope, q_rope], axis=-1)


def mla_keys_values(kv_lat, k_rope, p, rope):
    b, n, _ = kv_lat.shape
    kv = (rms_norm(kv_lat, p['mla_kv_norm']) @ p['mla_wukv']).reshape(b, n, MLA_HEADS, MLA_NOPE + MLA_V)
    k_nope = rms_norm(kv[..., :MLA_NOPE], p['mla_kn_nope'])
    k_r = rms_norm(k_rope, p['mla_kn_rope'])[:, :, None, :]
    if rope is not None:
        k_r = apply_axial_rope(k_r, rope)
    k = jnp.concatenate([k_nope, jnp.broadcast_to(k_r, (b, n, MLA_HEADS, MLA_ROPE))], axis=-1)
    return k, kv[..., MLA_NOPE:]


def block_attention(q, k, v):
    b, lq, h, dk = q.shape
    scale = dk ** -0.5
    qb = q.reshape(b, lq // ATTN_BLOCK, ATTN_BLOCK, h, dk).transpose(1, 0, 2, 3, 4)

    def one_block(qi):
        s = jnp.einsum('bqhd,bkhd->bhqk', qi, k).astype(jnp.float32) * scale
        pr = jax.nn.softmax(s, axis=-1).astype(v.dtype)
        return jnp.einsum('bhqk,bkhd->bqhd', pr, v)

    o = lax.map(one_block, qb)
    return o.transpose(1, 0, 2, 3, 4).reshape(b, lq, h, v.shape[-1])


def hyena_filter_spectra(n, p):
    f32 = jnp.float32
    t = jnp.linspace(0.0, 1.0, n, dtype=f32)[:, None]
    bands = (HY_EMB - 1) // 2
    w = 2 * math.pi * jnp.arange(n, dtype=f32)[:, None] / n
    f = jnp.linspace(1e-4, bands - 1, bands, dtype=f32)[None, :]
    feats = jnp.concatenate([t, jnp.cos(f * w), -jnp.sin(f * w)], axis=-1)
    h = jnp.sin(HY_SIN_FREQ * (feats @ p['hy_ffn_w1'].astype(f32) + p['hy_ffn_b1'].astype(f32)))
    h = jnp.sin(HY_SIN_FREQ * (h @ p['hy_ffn_w2'].astype(f32) + p['hy_ffn_b2'].astype(f32)))
    h = (h @ p['hy_ffn_w3'].astype(f32)).reshape(n, 2, HY_ORDER, HY_WIDTH)
    deltas = jnp.abs(jnp.linspace(HY_MIN_DECAY, HY_MAX_DECAY, HY_WIDTH, dtype=f32))
    window = jnp.exp(-t * deltas[None, :]) + HY_WINDOW_SHIFT
    h = h * window[:, None, None, :]
    h_fwd, h_bwd = h[:, 0], h[:, 1]
    two_sided = jnp.concatenate([h_fwd[:1] + h_bwd[:1], h_fwd[1:], jnp.zeros_like(h_fwd[:1]), h_bwd[:0:-1]], axis=0)
    return jnp.fft.rfft(two_sided, axis=0)


def long_conv(u, h_spec, skip):
    n = u.shape[1]
    uf = u.astype(jnp.float32)
    y = jnp.fft.irfft(jnp.fft.rfft(uf, n=2 * n, axis=1) * h_spec[None], n=2 * n, axis=1)[:, :n]
    return (y + uf * skip.astype(jnp.float32)).astype(u.dtype)


def short_conv(u, w, b):
    n = u.shape[1]
    pad = (HY_SHORT - 1) // 2
    up = jnp.pad(u, ((0, 0), (pad, pad), (0, 0)))
    return sum(up[:, j:j + n] * w[j] for j in range(HY_SHORT)) + b


def hyena_mix(u, p):
    n = u.shape[1]
    x1, x2, v = jnp.split(short_conv(u, p['hy_conv_w'], p['hy_conv_b']), HY_ORDER + 1, axis=-1)
    spec = hyena_filter_spectra(n, p)
    y = v
    for o, gate in enumerate((x1, x2)):
        y = gate * long_conv(y, spec[:, o], p['hy_skip'][o])
    return y


def to_heads(z, d):
    b, n, _ = z.shape
    return z.reshape(b, n, -1, d).transpose(0, 2, 1, 3).astype(jnp.float32)


def retention_scan(q, k, v, log_gamma, s0):
    b, h, n, dk = q.shape
    dv = v.shape[-1]
    nc = n // RET_CHUNK
    idx = jnp.arange(RET_CHUNK, dtype=jnp.float32)
    diff = idx[:, None] - idx[None, :]
    lg = log_gamma[:, None, None]
    intra_decay = jnp.where(diff >= 0, jnp.exp(lg * jnp.maximum(diff, 0.0)), 0.0)
    q_decay = jnp.exp(log_gamma[:, None] * (idx + 1.0))
    k_decay = jnp.exp(log_gamma[:, None] * (RET_CHUNK - 1.0 - idx))
    chunk_decay = jnp.exp(log_gamma * RET_CHUNK)
    qc = q.reshape(b, h, nc, RET_CHUNK, dk)
    kc = k.reshape(b, h, nc, RET_CHUNK, dk)
    vc = v.reshape(b, h, nc, RET_CHUNK, dv)
    scores = jnp.einsum('bhcid,bhcjd->bhcij', qc, kc) * intra_decay[None, :, None]
    o_intra = jnp.einsum('bhcij,bhcjv->bhciv', scores, vc)
    kv_chunk = jnp.einsum('bhcjd,bhcjv->cbhdv', kc * k_decay[None, :, None, :, None], vc)

    def step(s, kv):
        return chunk_decay[None, :, None, None] * s + kv, s

    _, s_prev = lax.scan(step, s0, kv_chunk)
    o_cross = jnp.einsum('bhcid,cbhdv->bhciv', qc, s_prev) * q_decay[None, :, None, :, None]
    return (o_intra + o_cross).reshape(b, h, n, dv)


def retention_context_state(k, v, log_gamma, backward):
    n = k.shape[2]
    pos = jnp.arange(n, dtype=jnp.float32)
    dist = pos if backward else (n - 1.0) - pos
    w = jnp.exp(log_gamma[:, None] * dist[None, :])
    return jnp.einsum('hn,bhnd,bhne->bhde', w, k, v)


def retention_mix(q, k, v, log_gamma, s0):
    fwd = retention_scan(q, k, v, log_gamma[0], s0[0])
    bwd = retention_scan(q[:, :, ::-1], k[:, :, ::-1], v[:, :, ::-1], log_gamma[1], s0[1])[:, :, ::-1]
    return fwd + bwd


def retention_output(o, gate, gn_w, gn_b):
    b, h, n, dv = o.shape
    mu = jnp.mean(o, axis=-1, keepdims=True)
    var = jnp.mean(jnp.square(o - mu), axis=-1, keepdims=True)
    o = ((o - mu) * lax.rsqrt(var + EPS)).transpose(0, 2, 1, 3).reshape(b, n, h * dv)
    o = o * gn_w.astype(jnp.float32) + gn_b.astype(jnp.float32)
    return (jax.nn.silu(gate.astype(jnp.float32)) * o).astype(gate.dtype)


def token_mixers(q_lat, keys, values, rq, rk, rv, s0, r_gate, hy_in, log_gamma, p, rope):
    b, n, _ = q_lat.shape
    q = mla_queries(q_lat, p, rope)
    attn = block_attention(q, keys, values).reshape(b, n, MLA_WIDTH)
    hy = hyena_mix(hy_in, p)
    ret = retention_mix(rq, rk, rv, log_gamma, s0)
    merged = jnp.concatenate([rms_norm(attn, p['mla_out_norm']),
                              rms_norm(hy, p['hy_out_norm']),
                              retention_output(ret, r_gate, p['ret_gn_w'], p['ret_gn_b'])], axis=-1)
    return merged @ p['w_out']


def trunk_layer(x, ctx, mod_x, mod_c, p, rope, need_ctx_out):
    sx1, cx1, gx1, sx2, cx2, gx2, sx3, cx3, gx3 = mod_x
    sc1, cc1, gc1, sc2, cc2, gc2, sc3, cc3, gc3 = mod_c
    ffn1 = (p['ffn1_gate'], p['ffn1_up'], p['ffn1_down'])
    ffn2 = (p['ffn2_gate'], p['ffn2_up'], p['ffn2_down'])

    x = x + 0.5 * gx1 * swiglu(modulate(x, sx1, cx1), *ffn1)
    ctx = ctx + 0.5 * gc1 * swiglu(modulate(ctx, sc1, cc1), *ffn1)

    log_gamma = jax.nn.log_sigmoid(p['ret_decay'].astype(jnp.float32))

    hc = modulate(ctx, sc2, cc2)
    if need_ctx_out:
        zc = split_cols(hc @ p['w_in'], COL_SIZES)
    else:
        zc = split_cols(hc @ p['w_in'][:, :N_KV_COLS], COL_SIZES[:4])
    k_c, v_c = mla_keys_values(zc[0], zc[1], p, None)
    rk_c = to_heads(zc[2], RET_DK) * RET_DK ** -0.5
    rv_c = to_heads(zc[3], RET_DV)
    s_ctx = (retention_context_state(rk_c, rv_c, log_gamma[0], False),
             retention_context_state(rk_c, rv_c, log_gamma[1], True))

    kv_lat, k_rope, r_k, r_v, q_lat, r_q, r_gate, hy_in = split_cols(modulate(x, sx2, cx2) @ p['w_in'], COL_SIZES)
    k_x, v_x = mla_keys_values(kv_lat, k_rope, p, rope)
    mixed = token_mixers(q_lat, jnp.concatenate([k_c, k_x], axis=1), jnp.concatenate([v_c, v_x], axis=1),
                         to_heads(r_q, RET_DK), to_heads(r_k, RET_DK) * RET_DK ** -0.5, to_heads(r_v, RET_DV),
                         s_ctx, r_gate, hy_in, log_gamma, p, rope)
    x = x + gx2 * mixed

    x = x + 0.5 * gx3 * swiglu(modulate(x, sx3, cx3), *ffn2)

    if need_ctx_out:
        zero = jnp.zeros_like(s_ctx[0])
        mixed_c = token_mixers(zc[4], k_c, v_c, to_heads(zc[5], RET_DK), rk_c, rv_c, (zero, zero),
                               zc[6], zc[7], log_gamma, p, None)
        ctx = ctx + gc2 * mixed_c
        ctx = ctx + 0.5 * gc3 * swiglu(modulate(ctx, sc3, cc3), *ffn2)
    return x, ctx


def setup_inputs(seed: int = 0) -> dict:
    key = jax.random.key(seed)
    keys = iter(jax.random.split(key, 48))
    f32 = jnp.float32

    def normal(shape, scale):
        return jax.random.normal(next(keys), shape, f32) * scale

    def gain(shape):
        return 1.0 + normal(shape, 0.02)

    D, L, F = D_MODEL, DEPTH, FFN_HIDDEN
    gam = 1.0 - 2.0 ** (-5.0 - np.arange(RET_HEADS, dtype=np.float32))
    decay_logit = jnp.asarray(np.log(gam / (1.0 - gam)), f32)
    return {
        'x': normal((BATCH, SEQ, D), 1.0),
        'c': normal((BATCH, D), 1.0),
        'ctx': normal((BATCH, CTX_LEN, D), 1.0),
        'c_ctx': normal((D,), 1.0),
        'ada_w': normal((L, D, N_MOD * D), 0.5 * D ** -0.5),
        'ada_b': normal((L, N_MOD * D), 0.02),
        'ffn1_gate': normal((L, D, F), D ** -0.5),
        'ffn1_up': normal((L, D, F), D ** -0.5),
        'ffn1_down': normal((L, F, D), F ** -0.5),
        'w_in': normal((L, D, N_IN), D ** -0.5),
        'mla_q_norm': gain((L, MLA_Q_LORA)),
        'mla_wuq': normal((L, MLA_Q_LORA, MLA_HEADS * (MLA_NOPE + MLA_ROPE)), MLA_Q_LORA ** -0.5),
        'mla_kv_norm': gain((L, MLA_KV_LORA)),
        'mla_wukv': normal((L, MLA_KV_LORA, MLA_HEADS * (MLA_NOPE + MLA_V)), MLA_KV_LORA ** -0.5),
        'mla_qn_nope': gain((L, MLA_NOPE)),
        'mla_qn_rope': gain((L, MLA_ROPE)),
        'mla_kn_nope': gain((L, MLA_NOPE)),
        'mla_kn_rope': gain((L, MLA_ROPE)),
        'mla_out_norm': gain((L, MLA_WIDTH)),
        'hy_conv_w': normal((L, HY_SHORT, (HY_ORDER + 1) * HY_WIDTH), HY_SHORT ** -0.5),
        'hy_conv_b': normal((L, (HY_ORDER + 1) * HY_WIDTH), 0.02),
        'hy_ffn_w1': normal((L, HY_EMB, HY_FFN), HY_EMB ** -0.5),
        'hy_ffn_b1': normal((L, HY_FFN), 0.02),
        'hy_ffn_w2': normal((L, HY_FFN, HY_FFN), HY_FFN ** -0.5),
        'hy_ffn_b2': normal((L, HY_FFN), 0.02),
        'hy_ffn_w3': normal((L, HY_FFN, 2 * HY_ORDER * HY_WIDTH), HY_FFN ** -0.5),
        'hy_skip': normal((L, HY_ORDER, HY_WIDTH), 1.0),
        'hy_out_norm': gain((L, HY_WIDTH)),
        'ret_decay': decay_logit[None, None, :] + normal((L, 2, RET_HEADS), 0.05),
        'ret_gn_w': gain((L, RET_WIDTH)),
        'ret_gn_b': normal((L, RET_WIDTH), 0.02),
        'w_out': normal((L, D, D), D ** -0.5),
        'ffn2_gate': normal((L, D, F), D ** -0.5),
        'ffn2_up': normal((L, D, F), D ** -0.5),
        'ffn2_down': normal((L, F, D), F ** -0.5),
    }


def reference(x, c, ctx, c_ctx, ada_w, ada_b, ffn1_gate, ffn1_up, ffn1_down, w_in,
              mla_q_norm, mla_wuq, mla_kv_norm, mla_wukv, mla_qn_nope, mla_qn_rope,
              mla_kn_nope, mla_kn_rope, mla_out_norm, hy_conv_w, hy_conv_b, hy_ffn_w1,
              hy_ffn_b1, hy_ffn_w2, hy_ffn_b2, hy_ffn_w3, hy_skip, hy_out_norm, ret_decay,
              ret_gn_w, ret_gn_b, w_out, ffn2_gate, ffn2_up, ffn2_down):
    ROWS = x.shape[1] // GRID_W
    rope = axial_rope_tables(ROWS, x.dtype)
    for l in range(DEPTH):
        p = {
            'ffn1_gate': ffn1_gate[l], 'ffn1_up': ffn1_up[l], 'ffn1_down': ffn1_down[l],
            'w_in': w_in[l],
            'mla_q_norm': mla_q_norm[l], 'mla_wuq': mla_wuq[l],
            'mla_kv_norm': mla_kv_norm[l], 'mla_wukv': mla_wukv[l],
            'mla_qn_nope': mla_qn_nope[l], 'mla_qn_rope': mla_qn_rope[l],
            'mla_kn_nope': mla_kn_nope[l], 'mla_kn_rope': mla_kn_rope[l],
            'mla_out_norm': mla_out_norm[l],
            'hy_conv_w': hy_conv_w[l], 'hy_conv_b': hy_conv_b[l],
            'hy_ffn_w1': hy_ffn_w1[l], 'hy_ffn_b1': hy_ffn_b1[l],
            'hy_ffn_w2': hy_ffn_w2[l], 'hy_ffn_b2': hy_ffn_b2[l], 'hy_ffn_w3': hy_ffn_w3[l],
            'hy_skip': hy_skip[l], 'hy_out_norm': hy_out_norm[l],
            'ret_decay': ret_decay[l], 'ret_gn_w': ret_gn_w[l], 'ret_gn_b': ret_gn_b[l],
            'w_out': w_out[l],
            'ffn2_gate': ffn2_gate[l], 'ffn2_up': ffn2_up[l], 'ffn2_down': ffn2_down[l],
        }
        mod_x = modulation(c, ada_w[l], ada_b[l])
        mod_c = modulation(c_ctx, ada_w[l], ada_b[l])
        x, ctx = trunk_layer(x, ctx, mod_x, mod_c, p, rope, l < DEPTH - 1)
    return x
```

```cpp
#include <hip/hip_runtime.h>
#include <cstdio>
#include <cstdint>
#include <cmath>

namespace pg8 {
#define PG8_LAS __attribute__((address_space(3)))
typedef unsigned short bf16_t;
typedef short bf16x8 __attribute__((ext_vector_type(8)));
typedef float f32x4 __attribute__((ext_vector_type(4)));
typedef unsigned u32x4 __attribute__((ext_vector_type(4)));
constexpr int BM = 256, BK = 64, HALF = 128, HTB = HALF * BK * 2, STAGE_BYTES = 8 * HTB, NXCD = 8, WGM = 4;

__host__ __device__ __forceinline__ int lds_byte(int r, int c) { const int st = (r >> 4) * 2 + (c >> 5), rr = r & 15, cc = c & 31, ob = rr * 64 + cc * 2; return st * 1024 + (ob ^ (((ob >> 9) & 1) << 5)); }
__host__ __device__ __forceinline__ void stage_rc(int b, int& R, int& C) { const int st = b / 1024, sb = b % 1024, swz = sb ^ (((sb >> 9) & 1) << 5); R = (st >> 1) * 16 + swz / 64; C = (st & 1) * 32 + (swz % 64) / 2; }
__host__ __device__ __forceinline__ int perm32(int rho) { const int n = rho >> 4, i = rho & 15; return 8 * (i >> 2) + 4 * n + (i & 3); }

struct Unit { int pm, pn, koff; };
struct Gemm { const bf16_t* A; const bf16_t* Bt; int M, N, K, ld; };

struct StaticOrder {
    int nM, nN, nwg, G, c;
    __host__ __device__ void init(int M, int N, int G_, int c_) { nM = M / BM; nN = N / BM; nwg = nM * nN; G = G_; c = c_; }
    __host__ __device__ bool next(int i, Unit& u) const {
        const long L = (long)i * G + c; if (L >= nwg) return false;
        int wgid = (int)L; { const int q = nwg / NXCD, r = nwg % NXCD, xcd = wgid % NXCD, off = wgid / NXCD; wgid = (xcd < r ? xcd * (q + 1) : r * (q + 1) + (xcd - r) * q) + off; }
        const int nig = WGM * nN, gid = wgid / nig, fm = gid * WGM, gsz = (nM - fm) < WGM ? (nM - fm) : WGM;
        u.pm = fm + ((wgid % nig) % gsz); u.pn = (wgid % nig) / gsz; u.koff = 0; return true;
    }
    __device__ __forceinline__ void a_ready(const Unit&) const {}
    __device__ __forceinline__ void done(const Unit&) const {}
};

struct SplitKOrder {
    int G, c, KS, kc;
    __device__ __forceinline__ bool next(int i, Unit& u) const { const int L = i * G + c; if (L >= 64 * KS) return false; const int ks = L % KS, t = L / KS; u.pn = t & 7; u.pm = t >> 3; u.koff = ks * kc * 2; return true; }
    __device__ __forceinline__ void a_ready(const Unit&) const {}
    __device__ __forceinline__ void done(const Unit&) const {}
};
__device__ __forceinline__ unsigned cvt_pk_bf16(float lo, float hi) { unsigned r; asm volatile("v_cvt_pk_bf16_f32 %0, %1, %2" : "=v"(r) : "v"(lo), "v"(hi)); return r; }

__device__ __forceinline__ float silu_f(float x) { return x * __builtin_amdgcn_rcpf(1.0f + __builtin_amdgcn_exp2f(-1.44269504089f * x)); }

struct EpiBf16 {
    static constexpr bool PERM = true, AFTER_DRAIN = false;
    bf16_t* O; int ldc;
    __device__ __forceinline__ void operator()(const f32x4 (&acc)[2][2][4][2], const Unit& u, int wr, int wc, int fr, int fq) const {
        const int row0 = u.pm * BM + wr * 64 + fr, col0 = u.pn * BM + wc * 32 + 8 * fq;
#pragma unroll
        for (int ai = 0; ai < 2; ++ai)
#pragma unroll
            for (int m = 0; m < 4; ++m) { bf16_t* rowp = O + (size_t)(row0 + ai * HALF + m * 16) * ldc + col0;
#pragma unroll
                for (int bj = 0; bj < 2; ++bj) { const f32x4 v0 = acc[ai][bj][m][0], v1 = acc[ai][bj][m][1];
                    u32x4 w; w.x = cvt_pk_bf16(v0[0], v0[1]); w.y = cvt_pk_bf16(v0[2], v0[3]); w.z = cvt_pk_bf16(v1[0], v1[1]); w.w = cvt_pk_bf16(v1[2], v1[3]);
                    *(u32x4*)(rowp + bj * HALF) = w; } }
    }
};
struct EpiSwiGLU {
    static constexpr bool PERM = true, AFTER_DRAIN = false;
    bf16_t* O; int ldc;
    __device__ __forceinline__ void operator()(const f32x4 (&acc)[2][2][4][2], const Unit& u, int wr, int wc, int fr, int fq) const {
        const int row0 = u.pm * BM + wr * 64 + fr, col0 = u.pn * HALF + wc * 32 + 8 * fq;
#pragma unroll
        for (int ai = 0; ai < 2; ++ai)
#pragma unroll
            for (int m = 0; m < 4; ++m) { bf16_t* rowp = O + (size_t)(row0 + ai * HALF + m * 16) * ldc + col0;
                const f32x4 g0 = acc[ai][0][m][0], g1 = acc[ai][0][m][1], u0 = acc[ai][1][m][0], u1 = acc[ai][1][m][1];
                float r[8];
#pragma unroll
                for (int j = 0; j < 4; ++j) { r[j] = silu_f(g0[j]) * u0[j]; r[4 + j] = silu_f(g1[j]) * u1[j]; }
                u32x4 w; w.x = cvt_pk_bf16(r[0], r[1]); w.y = cvt_pk_bf16(r[2], r[3]); w.z = cvt_pk_bf16(r[4], r[5]); w.w = cvt_pk_bf16(r[6], r[7]);
                *(u32x4*)rowp = w; }
    }
};
struct EpiPartial {
    static constexpr bool PERM = false, AFTER_DRAIN = false;
    float* part; int kbytes;
    __device__ __forceinline__ void operator()(const f32x4 (&acc)[2][2][4][2], const Unit& u, int wr, int wc, int fr, int fq) const {
        const int rl0 = wr * 64 + fr, col0 = u.pn * BM + wc * 32 + 4 * fq, ks = u.koff / kbytes;
        float* op = part + ((size_t)ks * 2048 + (size_t)u.pm * BM) * 2048;
#pragma unroll
        for (int ai = 0; ai < 2; ++ai)
#pragma unroll
            for (int m = 0; m < 4; ++m) { float* o = op + (size_t)(rl0 + ai * HALF + m * 16) * 2048 + col0;
#pragma unroll
                for (int bj = 0; bj < 2; ++bj)
#pragma unroll
                    for (int n = 0; n < 2; ++n) *(f32x4*)(o + bj * HALF + n * 16) = acc[ai][bj][m][n]; }
    }
};
struct EpiResid {
    static constexpr bool PERM = false, AFTER_DRAIN = false;
    const float* resx; const float* resc; float* outx; float* outc; const float* gate; float coef;
    __device__ __forceinline__ void operator()(const f32x4 (&acc)[2][2][4][2], const Unit& u, int wr, int wc, int fr, int fq) const {
        const int rl0 = wr * 64 + fr, col0 = u.pn * BM + wc * 32 + 4 * fq;
        const bool isx = u.pm < 64;
        const float* rp = isx ? resx + (size_t)u.pm * BM * 2048 : resc + (size_t)(u.pm - 64) * BM * 2048;
        float* op = isx ? outx + (size_t)u.pm * BM * 2048 : outc + (size_t)(u.pm - 64) * BM * 2048;
        const float* gp = gate + (size_t)(isx ? (u.pm >> 3) : 8) * 18432 + col0;
#pragma unroll
        for (int bj = 0; bj < 2; ++bj)
#pragma unroll
            for (int n = 0; n < 2; ++n) { const f32x4 gv = *(const f32x4*)(gp + bj * HALF + n * 16) * coef;
#pragma unroll
                for (int ai = 0; ai < 2; ++ai)
#pragma unroll
                    for (int m = 0; m < 4; ++m) { const size_t off = (size_t)(rl0 + ai * HALF + m * 16) * 2048 + col0 + bj * HALF + n * 16;
                        const f32x4 bs = *(const f32x4*)(rp + off);
                        *(f32x4*)(op + off) = bs + gv * acc[ai][bj][m][n]; }
                asm volatile("" ::: "memory"); }
    }
};

template <class Epi, class Sched, bool ALIGN_EPI = false, bool SP2 = false>
__device__ __forceinline__ void gemm_phase(PG8_LAS unsigned char* lds, const Gemm g, const Sched& S, const Epi& E, int tid) {
    asm volatile("" : "+v"(tid));
    const int  wid = __builtin_amdgcn_readfirstlane(tid >> 6), lane = tid & 63, wr = wid >> 2, wc = wid & 3, fr = lane & 15, fq = lane >> 4;
    const int K = g.ld, nt = g.K / BK;
    unsigned voffA[2], voffB[2];
#pragma unroll
    for (int i = 0; i < 2; ++i) { int R, C; stage_rc(tid * 16 + i * 8192, R, C); const int Rb = Epi::PERM ? ((R & ~31) + perm32(R & 31)) : R;
        voffA[i] = (unsigned)(R * K + C) * 2u; voffB[i] = (unsigned)(Rb * K + C) * 2u; }
    const size_t kstep = (size_t)(BK * 2);
    const size_t hstep = (size_t)HALF * K * 2;
    const size_t tstep = 2 * hstep;
    const unsigned ldsw = (unsigned)wid * 1024u;
    const int aoff = lds_byte(wr * 64 + fr, fq * 8), boff = lds_byte(wc * 32 + fr, fq * 8);
#define PG8_SA(b, h) (((b) * 2 + (h)) * HTB)
#define PG8_SB(b, h) ((4 + (b) * 2 + (h)) * HTB)
#define PG8_STAGE(bufoff, gbase, voff) do { _Pragma("unroll") for (int _i = 0; _i < 2; ++_i) \
        __builtin_amdgcn_global_load_lds((const unsigned*)((const char*)(gbase) + (voff)[_i]), (PG8_LAS unsigned*)(lds + (bufoff) + ldsw + _i * 8192), 16, 0, 0); } while (0)
#define PG8_LDA(dst, b, h) do { _Pragma("unroll") for (int m = 0; m < 4; ++m) _Pragma("unroll") for (int k = 0; k < 2; ++k) dst[m][k] = *(const PG8_LAS bf16x8*)(lds + PG8_SA(b, h) + aoff + m * 2048 + k * 1024); } while (0)
#define PG8_LDB(dst, b, h) do { _Pragma("unroll") for (int n = 0; n < 2; ++n) _Pragma("unroll") for (int k = 0; k < 2; ++k) dst[n][k] = *(const PG8_LAS bf16x8*)(lds + PG8_SB(b, h) + boff + n * 2048 + k * 1024); } while (0)
#define PG8_MMA(ai, bj, At, Bt) do { __builtin_amdgcn_s_setprio(1); _Pragma("unroll") for (int m = 0; m < 4; ++m) _Pragma("unroll") for (int n = 0; n < 2; ++n) _Pragma("unroll") for (int k = 0; k < 2; ++k) \
        acc[ai][bj][m][n] = __builtin_amdgcn_mfma_f32_16x16x32_bf16(Bt[n][k], At[m][k], acc[ai][bj][m][n], 0, 0, 0); __builtin_amdgcn_s_setprio(0); } while (0)
#define PG8_WAIT_V(n) asm volatile("s_waitcnt vmcnt(" #n ")" ::: "memory")
#define PG8_WAIT_L(n) asm volatile("s_waitcnt lgkmcnt(" #n ")" ::: "memory")
#define PG8_BAR __builtin_amdgcn_s_barrier()
#define PG8_SCHED __builtin_amdgcn_sched_barrier(0)
    Unit cur, nxt; int ui = 0;
    if (!S.next(0, cur)) return;
    f32x4 acc[2][2][4][2];
#pragma unroll
    for (int a = 0; a < 2; ++a)
#pragma unroll
        for (int b = 0; b < 2; ++b)
#pragma unroll
            for (int m = 0; m < 4; ++m)
#pragma unroll
                for (int n = 0; n < 2; ++n) acc[a][b][m][n] = (f32x4){0.f, 0.f, 0.f, 0.f};
    bf16x8 At[4][2], B0[2][2], B1[2][2];
    const char* cA = (const char*)g.A + (size_t)cur.pm * tstep + cur.koff; const char* cB = (const char*)g.Bt + (size_t)cur.pn * tstep + cur.koff;
    S.a_ready(cur);
    if constexpr (SP2) {
        PG8_STAGE(PG8_SB(0, 0), cB, voffB); PG8_STAGE(PG8_SB(0, 1), cB + hstep, voffB); PG8_STAGE(PG8_SA(0, 0), cA, voffA); PG8_STAGE(PG8_SA(0, 1), cA + hstep, voffA);
        if (wr == 1) PG8_BAR;
        PG8_WAIT_V(2); PG8_BAR;
        PG8_STAGE(PG8_SB(1, 0), cB + kstep, voffB); PG8_STAGE(PG8_SA(1, 0), cA + kstep, voffA); PG8_STAGE(PG8_SB(1, 1), cB + hstep + kstep, voffB);
        PG8_WAIT_V(6); PG8_BAR;
    } else {
        PG8_STAGE(PG8_SB(0, 0), cB, voffB); PG8_STAGE(PG8_SA(0, 0), cA, voffA); PG8_STAGE(PG8_SB(0, 1), cB + hstep, voffB); PG8_STAGE(PG8_SA(0, 1), cA + hstep, voffA);
        if (wr == 1) PG8_BAR;
        PG8_WAIT_V(4); PG8_BAR;
        PG8_STAGE(PG8_SB(1, 0), cB + kstep, voffB); PG8_STAGE(PG8_SA(1, 0), cA + kstep, voffA); PG8_STAGE(PG8_SB(1, 1), cB + hstep + kstep, voffB);
        PG8_WAIT_V(6); PG8_BAR;
    }
    for (;;) {
        const bool has_next = S.next(ui + 1, nxt);
        const char* nA = has_next ? (const char*)g.A + (size_t)nxt.pm * tstep + nxt.koff : cA; const char* nB = has_next ? (const char*)g.Bt + (size_t)nxt.pn * tstep + nxt.koff : cB;
        for (int t = 0; t < nt; t += 2) {
            const bool last = (t == nt - 2);
            const char* a1 = cA + (size_t)(t + 1) * kstep;
            const char* a2 = last ? nA : cA + (size_t)(t + 2) * kstep; const char* b2 = last ? nB : cB + (size_t)(t + 2) * kstep;
            const char* a3 = a2 + kstep; const char* b3 = b2 + kstep;
            if (last && has_next) S.a_ready(nxt);
            if constexpr (SP2) {
            PG8_LDB(B0, 0, 0); PG8_LDB(B1, 0, 1); PG8_SCHED; PG8_LDA(At, 0, 0); PG8_STAGE(PG8_SA(1, 1), a1 + hstep, voffA);
            PG8_WAIT_V(8); PG8_WAIT_L(0); PG8_BAR; PG8_MMA(0, 0, At, B0); PG8_MMA(0, 1, At, B1); PG8_BAR; PG8_SCHED;
            PG8_LDA(At, 0, 1); PG8_STAGE(PG8_SB(0, 0), b2, voffB); PG8_STAGE(PG8_SB(0, 1), b2 + hstep, voffB); PG8_STAGE(PG8_SA(0, 0), a2, voffA);
            PG8_WAIT_V(8); PG8_WAIT_L(0); PG8_BAR; PG8_MMA(1, 0, At, B0); PG8_MMA(1, 1, At, B1); PG8_BAR; PG8_SCHED;
            PG8_LDB(B0, 1, 0); PG8_LDB(B1, 1, 1); PG8_SCHED; PG8_LDA(At, 1, 0); PG8_STAGE(PG8_SA(0, 1), a2 + hstep, voffA);
            PG8_WAIT_V(8); PG8_WAIT_L(0); PG8_BAR; PG8_MMA(0, 0, At, B0); PG8_MMA(0, 1, At, B1); PG8_BAR; PG8_SCHED;
            PG8_LDA(At, 1, 1); PG8_STAGE(PG8_SB(1, 0), b3, voffB); PG8_STAGE(PG8_SB(1, 1), b3 + hstep, voffB); PG8_STAGE(PG8_SA(1, 0), a3, voffA);
            PG8_WAIT_V(8); PG8_WAIT_L(0); PG8_BAR; PG8_MMA(1, 0, At, B0); PG8_MMA(1, 1, At, B1); PG8_BAR; PG8_SCHED;
            } else {
            PG8_LDB(B0, 0, 0); PG8_SCHED; PG8_LDA(At, 0, 0); PG8_STAGE(PG8_SA(1, 1), a1 + hstep, voffA);
            PG8_WAIT_L(8); PG8_BAR; PG8_WAIT_L(0); PG8_MMA(0, 0, At, B0); PG8_BAR; PG8_SCHED;
            PG8_LDB(B1, 0, 1); PG8_STAGE(PG8_SB(0, 0), b2, voffB);
            PG8_BAR; PG8_WAIT_L(0); PG8_MMA(0, 1, At, B1); PG8_BAR;
            PG8_LDA(At, 0, 1); PG8_STAGE(PG8_SA(0, 0), a2, voffA);
            PG8_BAR; PG8_WAIT_L(0); PG8_MMA(1, 0, At, B0); PG8_BAR; PG8_SCHED;
            PG8_STAGE(PG8_SB(0, 1), b2 + hstep, voffB);
            PG8_WAIT_V(6); PG8_BAR; PG8_MMA(1, 1, At, B1); PG8_BAR;
            PG8_LDB(B0, 1, 0); PG8_SCHED; PG8_LDA(At, 1, 0); PG8_STAGE(PG8_SA(0, 1), a2 + hstep, voffA);
            PG8_WAIT_L(8); PG8_BAR; PG8_WAIT_L(0); PG8_MMA(0, 0, At, B0); PG8_BAR; PG8_SCHED;
            PG8_LDB(B1, 1, 1); PG8_STAGE(PG8_SB(1, 0), b3, voffB);
            PG8_BAR; PG8_WAIT_L(0); PG8_MMA(0, 1, At, B1); PG8_BAR;
            PG8_LDA(At, 1, 1); PG8_STAGE(PG8_SA(1, 0), a3, voffA);
            PG8_BAR; PG8_WAIT_L(0); PG8_MMA(1, 0, At, B0); PG8_BAR; PG8_SCHED;
            PG8_STAGE(PG8_SB(1, 1), b3 + hstep, voffB);
            PG8_WAIT_V(6); PG8_BAR; PG8_MMA(1, 1, At, B1); PG8_BAR;
            }
        }
        if constexpr (ALIGN_EPI) { if (wr == 0) PG8_BAR; }
        if constexpr (!Epi::AFTER_DRAIN) { E(acc, cur, wr, wc, fr, fq); S.done(cur); }
        if (!has_next) break;
#pragma unroll
        for (int a = 0; a < 2; ++a)
#pragma unroll
            for (int b = 0; b < 2; ++b)
#pragma unroll
                for (int m = 0; m < 4; ++m)
#pragma unroll
                    for (int n = 0; n < 2; ++n) acc[a][b][m][n] = (f32x4){0.f, 0.f, 0.f, 0.f};
        cur = nxt; cA = nA; cB = nB; ++ui;
        if constexpr (ALIGN_EPI) { if (wr == 1) PG8_BAR; }
    }
    PG8_WAIT_V(0);
    if constexpr (!ALIGN_EPI) { if (wr == 0) PG8_BAR; }
    PG8_BAR;
    if constexpr (Epi::AFTER_DRAIN) { E.fused(acc, cur, wr, wc, fr, fq, lds, wid, lane); S.done(cur); }
#undef PG8_SA
#undef PG8_SB
#undef PG8_STAGE
#undef PG8_LDA
#undef PG8_LDB
#undef PG8_MMA
#undef PG8_WAIT_V
#undef PG8_WAIT_L
#undef PG8_BAR
#undef PG8_SCHED
}
}

constexpr int NWAVES = 8, NTHR = 512;
constexpr int DM = 2048, NB = 8, SEQ = 2048, CTXL = 256, FF = 5632;
constexpr int TX = NB * SEQ, TC = NB * CTXL, TT = TX + TC;
constexpr int NMODC = 9 * DM;
constexpr float EPS = 1e-6f;
constexpr int ZC_KV = 0, ZC_RK = 256, ZC_RV = 512, ZC_KR = 1024, ZC_Q = 1280, ZC_RQ = 1792, ZC_RG = 2048, ZLD = 2560;
constexpr int NPH_L = 14, NPH = 2 + 2 * NPH_L;

enum { IN_X = 0, IN_C, IN_CTX, IN_CCTX, IN_ADAW, IN_ADAB, IN_F1G, IN_F1U, IN_F1D, IN_WIN, IN_QNORM, IN_WUQ, IN_KVNORM, IN_WUKV, IN_QNNOPE, IN_QNROPE, IN_KNNOPE, IN_KNROPE, IN_OUTNORM,
       IN_HCW, IN_HCB, IN_HW1, IN_HB1, IN_HW2, IN_HB2, IN_HW3, IN_HSKIP, IN_HONORM, IN_RDECAY, IN_RGNW, IN_RGNB, IN_WOUT, IN_F2G, IN_F2U, IN_F2D, N_IN };

constexpr size_t MiB = 1u << 20;
constexpr size_t SZ_WGU = (size_t)2 * FF * DM * 2, SZ_WD = (size_t)DM * FF * 2, SZ_WINM = (size_t)ZLD * DM * 2, SZ_WINH = (size_t)1536 * DM * 2,
                 SZ_WUQ = (size_t)1536 * 512 * 2, SZ_WUKV = (size_t)2048 * 256 * 2, SZ_WOUT = (size_t)DM * DM * 2;
constexpr size_t LW_GU1 = 0, LW_D1 = LW_GU1 + SZ_WGU, LW_GU2 = LW_D1 + SZ_WD, LW_D2 = LW_GU2 + SZ_WGU, LW_WINM = LW_D2 + SZ_WD, LW_WINH = LW_WINM + SZ_WINM,
                 LW_WUQ = LW_WINH + SZ_WINH, LW_WUKV = LW_WUQ + SZ_WUQ, LW_WOUT = LW_WUKV + SZ_WUKV, LW = LW_WOUT + SZ_WOUT;
constexpr size_t WS_CTL = 0, CTL_BYTES = 1 * MiB;
constexpr size_t WS_W = CTL_BYTES;
constexpr size_t WS_MODP = WS_W + 2 * LW;
constexpr size_t WS_MOD = WS_MODP + (size_t)2 * 8 * 9 * NMODC * 4;
constexpr size_t WS_H2 = WS_MOD + (size_t)2 * 9 * NMODC * 4;
constexpr size_t WS_H2C = WS_H2 + (size_t)2 * 2048 * 64 * 4;
constexpr size_t WS_TAPS = WS_H2C + (size_t)256 * 64 * 4;
constexpr size_t WS_TAPSC = WS_TAPS + (size_t)2 * 2 * 512 * 4096 * 4;
constexpr size_t WS_XRES = WS_TAPSC + (size_t)2 * 512 * 512 * 4;
constexpr size_t WS_HMOD = WS_XRES + (size_t)TT * DM * 4;
constexpr size_t WS_R = WS_HMOD + (size_t)TT * DM * 2;
constexpr size_t WS_G = WS_R;
constexpr size_t WS_Z = WS_R;
constexpr size_t WS_ZT = WS_Z + (size_t)TT * ZLD * 2;
constexpr size_t WS_KVN = WS_ZT + (size_t)1536 * TT * 2;
constexpr size_t WS_QN = WS_KVN + (size_t)TT * 256 * 2;
constexpr size_t WS_KROPE = WS_QN + (size_t)TT * 512 * 2;
constexpr size_t WS_KV = WS_KROPE + (size_t)TT * 64 * 2;
constexpr size_t WS_Q = WS_KV + (size_t)TT * 2048 * 2;
constexpr size_t WS_BQ = WS_Q + (size_t)TT * 1536 * 2;
constexpr size_t WS_AO = WS_BQ + (size_t)TT * 8 * 4;
constexpr size_t WS_HY = WS_AO + (size_t)TT * 1024 * 2;
constexpr size_t WS_RO = WS_HY + (size_t)512 * TT * 4;
constexpr size_t WS_PART = WS_RO + (size_t)2 * TT * 512 * 4;
constexpr size_t WS_END = WS_PART + (size_t)4 * TC * DM * 4;
static_assert(WS_G + (size_t)TT * FF * 2 <= WS_END, "G fits in the region");
static_assert(WS_END <= (size_t)1207959552, "workspace map must fit 4x the largest input");
static_assert(WS_W % 256 == 0 && LW % 256 == 0 && WS_MODP % 256 == 0 && WS_XRES % 256 == 0 && WS_R % 256 == 0 && WS_ZT % 256 == 0 && WS_KV % 256 == 0 && WS_Q % 256 == 0 && WS_HY % 256 == 0, "alignment");

constexpr int CW_BAR = 4096;

constexpr int RING_BYTES = 131072, LDSCTL_OFF = RING_BYTES, MISC_OFF = LDSCTL_OFF + 320, LDS_BYTES = 147456;

#define GAS __attribute__((address_space(1)))
#define LAS __attribute__((address_space(3)))
typedef unsigned short bf16_t;
typedef unsigned v4u __attribute__((ext_vector_type(4)));
typedef unsigned v2u __attribute__((ext_vector_type(2)));
typedef float f32x4 __attribute__((ext_vector_type(4)));
#define LDS_WAIT() asm volatile("s_waitcnt lgkmcnt(0)" ::: "memory")
#define VM_WAIT() asm volatile("s_waitcnt vmcnt(0)" ::: "memory")
__device__ __forceinline__ unsigned f2bf(float f) { unsigned u = __builtin_bit_cast(unsigned, f); return (u + 0x7fffu + ((u >> 16) & 1u)) >> 16; }
__device__ __forceinline__ unsigned pk2(float lo, float hi) { return f2bf(lo) | (f2bf(hi) << 16); }
__device__ __forceinline__ float bflo(unsigned w) { return __builtin_bit_cast(float, w << 16); }
__device__ __forceinline__ float bfhi(unsigned w) { return __builtin_bit_cast(float, w & 0xffff0000u); }
__device__ __forceinline__ float bf1(bf16_t b) { return __builtin_bit_cast(float, (unsigned)b << 16); }
template <int M> __device__ __forceinline__ float sx(float v) { static_assert(M >= 1 && M <= 16, "xor mask inside a 32-lane half"); return __builtin_bit_cast(float, __builtin_amdgcn_ds_swizzle(__builtin_bit_cast(int, v), (M << 10) | 0x1f)); }
__device__ __forceinline__ float half_sum(float v) { const int u = __builtin_bit_cast(int, v); return __builtin_bit_cast(float, __builtin_amdgcn_readlane(u, 0)) + __builtin_bit_cast(float, __builtin_amdgcn_readlane(u, 32)); }
__device__ __forceinline__ float half_max(float v) { const int u = __builtin_bit_cast(int, v); return fmaxf(__builtin_bit_cast(float, __builtin_amdgcn_readlane(u, 0)), __builtin_bit_cast(float, __builtin_amdgcn_readlane(u, 32))); }
__device__ __forceinline__ float wave_sum(float v) { v += sx<1>(v); v += sx<2>(v); v += sx<4>(v); v += sx<8>(v); v += sx<16>(v); return half_sum(v); }
__device__ __forceinline__ float wave_max(float v) { v = fmaxf(v, sx<1>(v)); v = fmaxf(v, sx<2>(v)); v = fmaxf(v, sx<4>(v)); v = fmaxf(v, sx<8>(v)); v = fmaxf(v, sx<16>(v)); return half_max(v); }
__device__ __forceinline__ float dot8(v4u a, v4u b, float s) {
    s = fmaf(bflo(a.x), bflo(b.x), s); s = fmaf(bfhi(a.x), bfhi(b.x), s); s = fmaf(bflo(a.y), bflo(b.y), s); s = fmaf(bfhi(a.y), bfhi(b.y), s);
    s = fmaf(bflo(a.z), bflo(b.z), s); s = fmaf(bfhi(a.z), bfhi(b.z), s); s = fmaf(bflo(a.w), bflo(b.w), s); s = fmaf(bfhi(a.w), bfhi(b.w), s); return s;
}

#define XB_TMO      128
#define XB_XCNT(j)  (256  + 64 * (j))
#define XB_XSUB(j)  (1280 + 64 * (j))
#define XB_XGEN(j)  (2304 + 64 * (j))
#define XB_TOP      3328
#define XB_TOPGEN   3392
#define XCD_BAR_WORDS 3456
#define XB_SPIN_CAP (1u << 22)
__device__ __forceinline__ unsigned xb_ld(unsigned* p)              { return __hip_atomic_load(p, __ATOMIC_RELAXED, __HIP_MEMORY_SCOPE_AGENT); }
__device__ __forceinline__ unsigned xb_add(unsigned* p, unsigned v) { return __hip_atomic_fetch_add(p, v, __ATOMIC_RELAXED, __HIP_MEMORY_SCOPE_AGENT); }
__device__ __forceinline__ unsigned xb_xcc_id() { return (unsigned)__builtin_amdgcn_s_getreg((3 << 11) | 20) & 0xFu; }
#define XB_SPIN(cond, bar) do { unsigned _sp = 0; while (cond) { __builtin_amdgcn_s_sleep(1); \
    if ((++_sp & 255u) == 0u) { if (xb_ld(&(bar)[XB_TMO])) break; if (_sp > XB_SPIN_CAP) { atomicAdd(&(bar)[XB_TMO], 1u); break; } } } } while (0)
struct XcdBarrier { unsigned* bar; unsigned x; volatile LAS unsigned* st; };
__device__ __forceinline__ XcdBarrier xcd_barrier_post(unsigned* bar, volatile LAS unsigned* st, int tid) {
    XcdBarrier b; b.bar = bar; b.x = xb_xcc_id(); b.st = st;
    if (tid == 0) (void)xb_add(&bar[XB_XCNT(b.x)], 1u);
    return b;
}
__device__ __forceinline__ void xcd_barrier_complete(unsigned* bar, unsigned x, unsigned& nloc, unsigned& nx) {
    const unsigned G = gridDim.x * gridDim.y * gridDim.z;
    unsigned sum, cnt, mine, sp = 0u;
    for (;;) {
        sum = 0u; cnt = 0u; mine = 0u;
#pragma unroll
        for (unsigned j = 0; j < 16; ++j) { const unsigned c = xb_ld(&bar[XB_XCNT(j)]); sum += c; cnt += (c > 0u) ? 1u : 0u; mine = (j == x) ? c : mine; }
        if (sum == G) break;
        __builtin_amdgcn_s_sleep(1);
        if ((++sp & 255u) == 0u) { if (xb_ld(&bar[XB_TMO])) break; if (sp > XB_SPIN_CAP) { atomicAdd(&bar[XB_TMO], 1u); break; } }
    }
    nloc = mine > 0u ? mine : 1u; nx = cnt > 0u ? cnt : 1u;
}
__device__ __forceinline__ void xcd_barrier(const XcdBarrier& b, int tid) {
    asm volatile("s_waitcnt vmcnt(0)" ::: "memory");
    __syncthreads();
    if (tid == 0) {
        unsigned* bar = b.bar;
        __builtin_amdgcn_s_waitcnt(0);
        unsigned nloc = b.st[0], nx = b.st[1];
        if (nloc == 0u) { xcd_barrier_complete(bar, b.x, nloc, nx); b.st[0] = nloc; b.st[1] = nx; }
        const unsigned old = xb_add(&bar[XB_XSUB(b.x)], 1u);
        const unsigned gen = old / nloc;
        if (old + 1u == (gen + 1u) * nloc) {
            __builtin_amdgcn_fence(__ATOMIC_RELEASE, "agent");
            asm volatile("s_waitcnt vmcnt(0)" ::: "memory");
            const unsigned og = xb_add(&bar[XB_TOP], 1u);
            const unsigned tg = og / nx;
            if (og + 1u == (tg + 1u) * nx) xb_add(&bar[XB_TOPGEN], 1u);
            else XB_SPIN(xb_ld(&bar[XB_TOPGEN]) == tg, bar);
            __builtin_amdgcn_fence(__ATOMIC_ACQUIRE, "agent");
            xb_add(&bar[XB_XGEN(b.x)], 1u);
            asm volatile("s_waitcnt vmcnt(0)" ::: "memory");
        } else {
            XB_SPIN(xb_ld(&bar[XB_XGEN(b.x)]) == gen, bar);
            __builtin_amdgcn_fence(__ATOMIC_ACQUIRE, "agent");
            asm volatile("s_waitcnt vmcnt(0)" ::: "memory");
        }
    }
    __syncthreads();
}

struct Args { const float* in[N_IN]; float* out; unsigned char* ws; int ph_lo, ph_hi, bar_sel, pad; };
struct Frame {
    LAS unsigned char* lds;
    int tid, lane, wave, G, gw, NGW, bid, wave0;
    const float* const* in; unsigned char* ws; float* out;
};
#define WSP(T, off) ((T*)(F.ws + (off)))

__device__ __forceinline__ void transpose_item(const float* W, int ldw, int K, int srccol0, bf16_t* WT, int dstrow0, int kb, LAS float* scr, int lane) {
    const int k0 = 64 * kb;
    if (W) {
#pragma unroll 8
        for (int i = 0; i < 32; ++i) { const int kk = 2 * i + (lane >> 5); scr[kk * 33 + (lane & 31)] = W[(size_t)(k0 + kk) * ldw + srccol0 + (lane & 31)]; }
    } else {
#pragma unroll 8
        for (int i = 0; i < 32; ++i) { const int kk = 2 * i + (lane >> 5); scr[kk * 33 + (lane & 31)] = 0.f; }
    }
    LDS_WAIT(); asm volatile("" ::: "memory");
    const int c = lane & 7;
#pragma unroll
    for (int j = 0; j < 4; ++j) { const int n = (lane >> 3) + 8 * j; const LAS float* s = scr + (8 * c) * 33 + n;
        v4u o; o.x = pk2(s[0 * 33], s[1 * 33]); o.y = pk2(s[2 * 33], s[3 * 33]); o.z = pk2(s[4 * 33], s[5 * 33]); o.w = pk2(s[6 * 33], s[7 * 33]);
        *(v4u*)(WT + (size_t)(dstrow0 + n) * K + k0 + 8 * c) = o; }
    LDS_WAIT(); asm volatile("" ::: "memory");
}
constexpr int J_GU_RB = 2 * FF / 32, J_GU_KB = DM / 64, J_D_RB = DM / 32, J_D_KB = FF / 64, J_WM_RB = ZLD / 32, J_WH_RB = 1536 / 32, J_IN_KB = DM / 64,
              J_UQ_RB = 1536 / 32, J_UQ_KB = 512 / 64, J_UKV_RB = 2048 / 32, J_UKV_KB = 256 / 64, J_O_RB = DM / 32, J_O_KB = DM / 64;
constexpr int JI_GU = J_GU_RB * J_GU_KB, JI_D = J_D_RB * J_D_KB, JI_WM = J_WM_RB * J_IN_KB, JI_WH = J_WH_RB * J_IN_KB, JI_UQ = J_UQ_RB * J_UQ_KB, JI_UKV = J_UKV_RB * J_UKV_KB, JI_O = J_O_RB * J_O_KB;
constexpr int JI_LAYER = 2 * JI_GU + 2 * JI_D + JI_WM + JI_WH + JI_UQ + JI_UKV + JI_O;
__device__ __forceinline__ void wprep_gu(const Frame& F, const float* Wg, const float* Wu, bf16_t* dst, int r, LAS float* scr) {
    const int rb = r / J_GU_KB, kb = r % J_GU_KB, tile = rb >> 3, within = rb & 7;
    const float* W = within < 4 ? Wg : Wu;
    transpose_item(W, FF, DM, tile * 128 + (within & 3) * 32, dst, rb * 32, kb, scr, F.lane);
}
__device__ __forceinline__ void p0_weights(const Frame& F) {
    LAS float* scr = (LAS float*)(F.lds + F.wave * 16384);
    for (int it = F.gw; it < 2 * JI_LAYER; it += F.NGW) {
        const int l = it / JI_LAYER; int r = it % JI_LAYER;
        unsigned char* wl = F.ws + WS_W + (size_t)l * LW;
        if (r < JI_GU) { wprep_gu(F, F.in[IN_F1G] + (size_t)l * DM * FF, F.in[IN_F1U] + (size_t)l * DM * FF, (bf16_t*)(wl + LW_GU1), r, scr); continue; } r -= JI_GU;
        if (r < JI_D) { transpose_item(F.in[IN_F1D] + (size_t)l * FF * DM, DM, FF, (r / J_D_KB) * 32, (bf16_t*)(wl + LW_D1), (r / J_D_KB) * 32, r % J_D_KB, scr, F.lane); continue; } r -= JI_D;
        if (r < JI_GU) { wprep_gu(F, F.in[IN_F2G] + (size_t)l * DM * FF, F.in[IN_F2U] + (size_t)l * DM * FF, (bf16_t*)(wl + LW_GU2), r, scr); continue; } r -= JI_GU;
        if (r < JI_D) { transpose_item(F.in[IN_F2D] + (size_t)l * FF * DM, DM, FF, (r / J_D_KB) * 32, (bf16_t*)(wl + LW_D2), (r / J_D_KB) * 32, r % J_D_KB, scr, F.lane); continue; } r -= JI_D;
        if (r < JI_WM) { const int rb = r / J_IN_KB, kb = r % J_IN_KB, d0 = rb * 32; int src;
            if (d0 < 256) src = d0; else if (d0 < 512) src = 320 + (d0 - 256); else if (d0 < 1024) src = 576 + (d0 - 512); else if (d0 < 1088) src = 256 + (d0 - 1024);
            else if (d0 < 1280) src = -1; else if (d0 < 1792) src = 1088 + (d0 - 1280); else if (d0 < 2048) src = 1600 + (d0 - 1792); else src = 1856 + (d0 - 2048);
            transpose_item(src < 0 ? nullptr : F.in[IN_WIN] + (size_t)l * DM * 3904, 3904, DM, src < 0 ? 0 : src, (bf16_t*)(wl + LW_WINM), d0, kb, scr, F.lane); continue; } r -= JI_WM;
        if (r < JI_WH) { const int rb = r / J_IN_KB, kb = r % J_IN_KB; transpose_item(F.in[IN_WIN] + (size_t)l * DM * 3904, 3904, DM, 2368 + rb * 32, (bf16_t*)(wl + LW_WINH), rb * 32, kb, scr, F.lane); continue; } r -= JI_WH;
        if (r < JI_UQ) { const int rb = r / J_UQ_KB, kb = r % J_UQ_KB; transpose_item(F.in[IN_WUQ] + (size_t)l * 512 * 1536, 1536, 512, rb * 32, (bf16_t*)(wl + LW_WUQ), rb * 32, kb, scr, F.lane); continue; } r -= JI_UQ;
        if (r < JI_UKV) { const int rb = r / J_UKV_KB, kb = r % J_UKV_KB; transpose_item(F.in[IN_WUKV] + (size_t)l * 256 * 2048, 2048, 256, rb * 32, (bf16_t*)(wl + LW_WUKV), rb * 32, kb, scr, F.lane); continue; } r -= JI_UKV;
        { const int rb = r / J_O_KB, kb = r % J_O_KB; transpose_item(F.in[IN_WOUT] + (size_t)l * DM * DM, DM, DM, rb * 32, (bf16_t*)(wl + LW_WOUT), rb * 32, kb, scr, F.lane); }
    }
}
__device__ __forceinline__ void p0_modpart(const Frame& F) {
    LAS float* sl = (LAS float*)F.lds;
    for (int it = F.bid; it < 2 * 36 * 8; it += F.G) {
        const int l = it / 288, rem = it % 288, jb = rem / 8, kc = rem % 8;
        __syncthreads();
        for (int idx = F.tid; idx < 9 * 256; idx += NTHR) { const int r = idx >> 8, k = idx & 255;
            const float cv = r < 8 ? F.in[IN_C][r * DM + kc * 256 + k] : F.in[IN_CCTX][kc * 256 + k];
            sl[idx] = cv / (1.0f + expf(-cv)); }
        __syncthreads();
        const int j = jb * 512 + F.tid;
        const float* wp = F.in[IN_ADAW] + ((size_t)l * DM + kc * 256) * NMODC + j;
        float acc[9];
#pragma unroll
        for (int r = 0; r < 9; ++r) acc[r] = 0.f;
        for (int k = 0; k < 256; k += 4) {
            float a[4];
#pragma unroll
            for (int q = 0; q < 4; ++q) a[q] = wp[(size_t)(k + q) * NMODC];
#pragma unroll
            for (int q = 0; q < 4; ++q)
#pragma unroll
                for (int r = 0; r < 9; ++r) acc[r] = fmaf(sl[r * 256 + k + q], a[q], acc[r]);
        }
        float* mp = WSP(float, WS_MOD) + ((size_t)l * 9) * NMODC + j;
        const float bias = kc == 0 ? F.in[IN_ADAB][l * NMODC + j] : 0.f;
#pragma unroll
        for (int r = 0; r < 9; ++r) unsafeAtomicAdd(mp + (size_t)r * NMODC, acc[r] + bias);
    }
    __syncthreads();
}
__device__ __forceinline__ void p0_hyh2(const Frame& F) {
    for (int it = F.gw; it < 2 * 2048 + 256; it += F.NGW) {
        const int l = it < 4096 ? it >> 11 : 0, type = it < 4096 ? 0 : 1, i = it < 4096 ? (it & 2047) : it - 4096, n = type ? 256 : 2048;
        const float t = (float)i / (float)(n - 1), w = (6.2831853071795864f * (float)i) / (float)n;
        float feat = 0.f;
        if (F.lane == 0) feat = t;
        else if (F.lane <= 32) { const int j = (F.lane - 1) & 15; const float f = 1e-4f + (float)j * ((15.0f - 1e-4f) / 15.0f); feat = F.lane <= 16 ? cosf(f * w) : -sinf(f * w); }
        const float* W1 = F.in[IN_HW1] + (size_t)l * 33 * 64; const float* W2 = F.in[IN_HW2] + (size_t)l * 64 * 64;
        float a = F.in[IN_HB1][l * 64 + F.lane];
#pragma unroll
        for (int f = 0; f < 33; ++f) a = fmaf(__shfl(feat, f), W1[f * 64 + F.lane], a);
        const float h1 = sinf(a);
        float b = F.in[IN_HB2][l * 64 + F.lane];
#pragma unroll 8
        for (int k = 0; k < 64; ++k) b = fmaf(__shfl(h1, k), W2[k * 64 + F.lane], b);
        const float h2 = sinf(b);
        float* dst = type ? WSP(float, WS_H2C) + (size_t)i * 64 : WSP(float, WS_H2) + ((size_t)l * 2048 + i) * 64;
        dst[F.lane] = h2;
    }
}
__device__ __forceinline__ void p1_mod(const Frame& F) {
    for (int e = F.bid * NTHR + F.tid; e < 2 * 9 * NMODC; e += F.G * NTHR) {
        const int l = e / (9 * NMODC), rem = e % (9 * NMODC), r = rem / NMODC, j = rem % NMODC;
        float s = F.in[IN_ADAB][l * NMODC + j];
#pragma unroll
        for (int kc = 0; kc < 8; ++kc) s += WSP(float, WS_MODP)[((size_t)(l * 8 + kc) * 9 + r) * NMODC + j];
        WSP(float, WS_MOD)[e] = s;
    }
}
__device__ __forceinline__ void p1_taps(const Frame& F) {
    LAS float* wl = (LAS float*)(F.lds + F.wave * 8192);
    for (int it = F.gw; it < 4096 + 256; it += F.NGW) {
        const int type = it < 4096 ? 0 : 1, r = type ? it - 4096 : it, l = type ? 0 : r >> 11, ib = type ? r >> 6 : (r >> 6) & 31, cbk = r & 63, o = cbk >> 5, c0 = (cbk & 31) * 16, n = type ? 256 : 2048;
        const int i = ib * 64 + F.lane;
        const float* h2 = (type ? WSP(float, WS_H2C) : WSP(float, WS_H2) + (size_t)l * 2048 * 64) + (size_t)i * 64;
        f32x4 hv[16];
#pragma unroll
        for (int q = 0; q < 16; ++q) hv[q] = *((const f32x4*)h2 + q);
        const float* W3 = F.in[IN_HW3] + (size_t)l * 64 * 2048 + (size_t)F.lane * 2048 + o * 512 + c0;
#pragma unroll
        for (int dir = 0; dir < 2; ++dir)
#pragma unroll
            for (int q = 0; q < 4; ++q) { const f32x4 w = *((const f32x4*)(W3 + dir * 1024) + q);
#pragma unroll
                for (int e = 0; e < 4; ++e) wl[(dir * 16 + q * 4 + e) * 64 + F.lane] = w[e]; }
        LDS_WAIT(); asm volatile("" ::: "memory");
        const float t = (float)i / (float)(n - 1);
        const float dmin = -3.0701134573f, dmax = -15.350567286f;
        for (int cc = 0; cc < 16; ++cc) {
            float sf = 0.f, sb = 0.f;
            const LAS f32x4* wf = (const LAS f32x4*)(wl + cc * 64); const LAS f32x4* wb = (const LAS f32x4*)(wl + (16 + cc) * 64);
#pragma unroll
            for (int q = 0; q < 16; ++q) { const f32x4 a = wf[q], bq = wb[q], h = hv[q];
                sf = fmaf(h[0], a[0], sf); sf = fmaf(h[1], a[1], sf); sf = fmaf(h[2], a[2], sf); sf = fmaf(h[3], a[3], sf);
                sb = fmaf(h[0], bq[0], sb); sb = fmaf(h[1], bq[1], sb); sb = fmaf(h[2], bq[2], sb); sb = fmaf(h[3], bq[3], sb); }
            const int c = c0 + cc;
            const float delta = fabsf(dmin + (float)c * ((dmax - dmin) / 511.0f)), win = expf(-t * delta) + 0.05f;
            float* dst = type ? WSP(float, WS_TAPSC) + ((size_t)o * 512 + c) * 512 : WSP(float, WS_TAPS) + (((size_t)l * 2 + o) * 512 + c) * 4096;
            if (i == 0) { dst[0] = (sf + sb) * win; dst[n] = 0.f; } else { dst[i] = sf * win; dst[2 * n - i] = sb * win; }
        }
        LDS_WAIT(); asm volatile("" ::: "memory");
    }
}

__device__ __forceinline__ void norm_row(const Frame& F, int row, const float* srcx, const float* srcc, const float* modl, int shift_idx, int scale_idx, bf16_t* dst, const float* part, const float* pgate, float* xout, float pcoef) {
    const float* xr = row < TX ? srcx + (size_t)row * DM : srcc + (size_t)(row - TX) * DM;
    const int mrow = row < TX ? row >> 11 : 8;
    const f32x4* xv = (const f32x4*)xr + F.lane;
    f32x4 v[8]; float ss = 0.f;
#pragma unroll
    for (int j = 0; j < 8; ++j) { v[j] = xv[64 * j]; ss += (v[j][0] * v[j][0] + v[j][1] * v[j][1]) + (v[j][2] * v[j][2] + v[j][3] * v[j][3]); }
    if (part && row >= TX) {
        const f32x4* pp = (const f32x4*)(part + (size_t)(row - TX) * DM) + F.lane; const f32x4* gp = (const f32x4*)pgate + F.lane; f32x4* xo = (f32x4*)(xout + (size_t)(row - TX) * DM) + F.lane;
        ss = 0.f;
#pragma unroll
        for (int j = 0; j < 8; ++j) { const f32x4 s4 = (pp[64 * j] + pp[64 * j + (size_t)TC * DM / 4]) + (pp[64 * j + (size_t)2 * TC * DM / 4] + pp[64 * j + (size_t)3 * TC * DM / 4]);
            v[j] = v[j] + gp[64 * j] * pcoef * s4; xo[64 * j] = v[j]; ss += (v[j][0] * v[j][0] + v[j][1] * v[j][1]) + (v[j][2] * v[j][2] + v[j][3] * v[j][3]); }
    }
    const float rstd = 1.0f / sqrtf(wave_sum(ss) * (1.0f / DM) + EPS);
    const f32x4* sh = (const f32x4*)(modl + (size_t)mrow * NMODC + shift_idx * DM) + F.lane;
    const f32x4* sc = (const f32x4*)(modl + (size_t)mrow * NMODC + scale_idx * DM) + F.lane;
    v2u* o = (v2u*)(dst + (size_t)row * DM) + F.lane;
#pragma unroll
    for (int j = 0; j < 8; ++j) { const f32x4 s = sh[64 * j], c = sc[64 * j]; const f32x4 y = v[j] * rstd * (c + 1.0f) + s;
        v2u w; w.x = pk2(y[0], y[1]); w.y = pk2(y[2], y[3]); o[64 * j] = w; }
}
__device__ __forceinline__ void norm_phase(const Frame& F, const float* srcx, const float* srcc, int nrows, const float* modl, int shift_idx, int scale_idx, bf16_t* dst, const float* part, const float* pgate, float* xout, float pcoef = 0.5f) {
    for (int row = F.gw; row < nrows; row += 2 * F.NGW) {
        const int row2 = row + F.NGW;
        if (row2 < nrows && !(part && row2 >= TX) && !(part && row >= TX)) {
            const float* xa = row < TX ? srcx + (size_t)row * DM : srcc + (size_t)(row - TX) * DM; const float* xb = row2 < TX ? srcx + (size_t)row2 * DM : srcc + (size_t)(row2 - TX) * DM;
            const int ma = row < TX ? row >> 11 : 8, mb = row2 < TX ? row2 >> 11 : 8;
            const f32x4* xva = (const f32x4*)xa + F.lane; const f32x4* xvb = (const f32x4*)xb + F.lane;
            f32x4 va[8], vb[8]; float sa = 0.f, sb = 0.f;
#pragma unroll
            for (int j = 0; j < 8; ++j) { va[j] = xva[64 * j]; vb[j] = xvb[64 * j]; }
#pragma unroll
            for (int j = 0; j < 8; ++j) { sa += (va[j][0] * va[j][0] + va[j][1] * va[j][1]) + (va[j][2] * va[j][2] + va[j][3] * va[j][3]); sb += (vb[j][0] * vb[j][0] + vb[j][1] * vb[j][1]) + (vb[j][2] * vb[j][2] + vb[j][3] * vb[j][3]); }
            const float ra = 1.0f / sqrtf(wave_sum(sa) * (1.0f / DM) + EPS), rb = 1.0f / sqrtf(wave_sum(sb) * (1.0f / DM) + EPS);
            const f32x4* sha = (const f32x4*)(modl + (size_t)ma * NMODC + shift_idx * DM) + F.lane; const f32x4* sca = (const f32x4*)(modl + (size_t)ma * NMODC + scale_idx * DM) + F.lane;
            const f32x4* shb = (const f32x4*)(modl + (size_t)mb * NMODC + shift_idx * DM) + F.lane; const f32x4* scb = (const f32x4*)(modl + (size_t)mb * NMODC + scale_idx * DM) + F.lane;
            v2u* oa = (v2u*)(dst + (size_t)row * DM) + F.lane; v2u* ob = (v2u*)(dst + (size_t)row2 * DM) + F.lane;
#pragma unroll
            for (int j = 0; j < 8; ++j) { const f32x4 ya = va[j] * ra * (sca[64 * j] + 1.0f) + sha[64 * j], yb = vb[j] * rb * (scb[64 * j] + 1.0f) + shb[64 * j];
                v2u w; w.x = pk2(ya[0], ya[1]); w.y = pk2(ya[2], ya[3]); oa[64 * j] = w; w.x = pk2(yb[0], yb[1]); w.y = pk2(yb[2], yb[3]); ob[64 * j] = w; }
        } else {
            norm_row(F, row, srcx, srcc, modl, shift_idx, scale_idx, dst, part, pgate, xout, pcoef);
            if (row2 < nrows) norm_row(F, row2, srcx, srcc, modl, shift_idx, scale_idx, dst, part, pgate, xout, pcoef);
        }
    }
}

__device__ __forceinline__ float rope_invfreq(int i) { return powf(10000.0f, -(float)i / 16.0f); }
__device__ __forceinline__ void postproj_phase(const Frame& F, int l) {
    const bf16_t* Z = WSP(bf16_t, WS_Z);
    const float* gkv = F.in[IN_KVNORM] + l * 256; const float* gq = F.in[IN_QNORM] + l * 512; const float* gkr = F.in[IN_KNROPE] + l * 64;
    for (int row = F.gw; row < TT; row += F.NGW) {
        const bf16_t* zr = Z + (size_t)row * ZLD;
        {
            const v2u w = *((const v2u*)(zr + ZC_KV) + F.lane);
            const float a0 = bflo(w.x), a1 = bfhi(w.x), a2 = bflo(w.y), a3 = bfhi(w.y);
            const float rstd = 1.0f / sqrtf(wave_sum(a0 * a0 + a1 * a1 + a2 * a2 + a3 * a3) * (1.0f / 256.0f) + EPS);
            const f32x4 g = *((const f32x4*)gkv + F.lane);
            v2u o; o.x = pk2(a0 * rstd * g[0], a1 * rstd * g[1]); o.y = pk2(a2 * rstd * g[2], a3 * rstd * g[3]);
            *((v2u*)(WSP(bf16_t, WS_KVN) + (size_t)row * 256) + F.lane) = o;
        }
        {
            const v4u w = *((const v4u*)(zr + ZC_Q) + F.lane);
            float a[8] = {bflo(w.x), bfhi(w.x), bflo(w.y), bfhi(w.y), bflo(w.z), bfhi(w.z), bflo(w.w), bfhi(w.w)};
            float ss = 0.f;
#pragma unroll
            for (int j = 0; j < 8; ++j) ss += a[j] * a[j];
            const float rstd = 1.0f / sqrtf(wave_sum(ss) * (1.0f / 512.0f) + EPS);
            const f32x4 g0 = *((const f32x4*)gq + 2 * F.lane), g1 = *((const f32x4*)gq + 2 * F.lane + 1);
            v4u o; o.x = pk2(a[0] * rstd * g0[0], a[1] * rstd * g0[1]); o.y = pk2(a[2] * rstd * g0[2], a[3] * rstd * g0[3]);
            o.z = pk2(a[4] * rstd * g1[0], a[5] * rstd * g1[1]); o.w = pk2(a[6] * rstd * g1[2], a[7] * rstd * g1[3]);
            *((v4u*)(WSP(bf16_t, WS_QN) + (size_t)row * 512) + F.lane) = o;
        }
        {
            const float a = bf1(zr[ZC_KR + F.lane]);
            const float rstd = 1.0f / sqrtf(wave_sum(a * a) * (1.0f / 64.0f) + EPS);
            float y = a * rstd * gkr[F.lane];
            if (row < TX) {
                const int t = row & (SEQ - 1), d = F.lane, within = d & 31, i = within & 15;
                const float pos = (float)((d >> 5) ? (t & 63) : (t >> 6));
                const float ang = pos * rope_invfreq(i);
                const float cs = cosf(ang), sn = sinf(ang);
                const float other = sx<16>(y);
                y = within < 16 ? y * cs - other * sn : other * sn + y * cs;
            }
            WSP(bf16_t, WS_KROPE)[(size_t)row * 64 + F.lane] = (bf16_t)f2bf(y);
        }
    }
}

constexpr float QSCALE = 0.07216878364870322f * 1.4426950408889634f;
__device__ __forceinline__ void headnorm_phase(const Frame& F, int l) {
    const float* gkn = F.in[IN_KNNOPE] + l * 128; const float* gqn = F.in[IN_QNNOPE] + l * 128; const float* gqr = F.in[IN_QNROPE] + l * 64; const float* gkr = F.in[IN_KNROPE] + l * 64;
    float m1 = fmaxf(fabsf(gkn[F.lane]), fabsf(gkn[64 + F.lane])), m2 = fabsf(gkr[F.lane]);
    m1 = wave_max(m1); m2 = wave_max(m2);
    const float kbound = 1.02f * sqrtf(128.0f * m1 * m1 + 64.0f * m2 * m2);
    const int nq = (l == 0) ? TT : TX;
    const int h = F.lane >> 3, s8 = F.lane & 7;
    for (int row = F.gw; row < TT; row += F.NGW) {
        {
            v4u* kp = (v4u*)(WSP(bf16_t, WS_KV) + (size_t)row * 2048 + h * 256 + s8 * 16);
            const v4u w0 = kp[0], w1 = kp[1];
            float a[16] = {bflo(w0.x), bfhi(w0.x), bflo(w0.y), bfhi(w0.y), bflo(w0.z), bfhi(w0.z), bflo(w0.w), bfhi(w0.w),
                           bflo(w1.x), bfhi(w1.x), bflo(w1.y), bfhi(w1.y), bflo(w1.z), bfhi(w1.z), bflo(w1.w), bfhi(w1.w)};
            float ss = 0.f;
#pragma unroll
            for (int j = 0; j < 16; ++j) ss += a[j] * a[j];
            ss += sx<1>(ss); ss += sx<2>(ss); ss += sx<4>(ss);
            const float rstd = 1.0f / sqrtf(ss * (1.0f / 128.0f) + EPS);
            const float* g = gkn + s8 * 16;
            v4u o0, o1;
            o0.x = pk2(a[0] * rstd * g[0], a[1] * rstd * g[1]); o0.y = pk2(a[2] * rstd * g[2], a[3] * rstd * g[3]); o0.z = pk2(a[4] * rstd * g[4], a[5] * rstd * g[5]); o0.w = pk2(a[6] * rstd * g[6], a[7] * rstd * g[7]);
            o1.x = pk2(a[8] * rstd * g[8], a[9] * rstd * g[9]); o1.y = pk2(a[10] * rstd * g[10], a[11] * rstd * g[11]); o1.z = pk2(a[12] * rstd * g[12], a[13] * rstd * g[13]); o1.w = pk2(a[14] * rstd * g[14], a[15] * rstd * g[15]);
            kp[0] = o0; kp[1] = o1;
        }
        if (row < nq) {
            bf16_t* qrow = WSP(bf16_t, WS_Q) + (size_t)row * 1536 + h * 192;
            v4u* qp = (v4u*)(qrow + s8 * 16);
            const v4u w0 = qp[0], w1 = qp[1];
            float a[16] = {bflo(w0.x), bfhi(w0.x), bflo(w0.y), bfhi(w0.y), bflo(w0.z), bfhi(w0.z), bflo(w0.w), bfhi(w0.w),
                           bflo(w1.x), bfhi(w1.x), bflo(w1.y), bfhi(w1.y), bflo(w1.z), bfhi(w1.z), bflo(w1.w), bfhi(w1.w)};
            float ss = 0.f;
#pragma unroll
            for (int j = 0; j < 16; ++j) ss += a[j] * a[j];
            ss += sx<1>(ss); ss += sx<2>(ss); ss += sx<4>(ss);
            const float rstd = QSCALE / sqrtf(ss * (1.0f / 128.0f) + EPS);
            const float* g = gqn + s8 * 16;
            float qq = 0.f;
#pragma unroll
            for (int j = 0; j < 16; ++j) { a[j] = a[j] * rstd * g[j]; qq += a[j] * a[j]; }
            v4u o0, o1;
            o0.x = pk2(a[0], a[1]); o0.y = pk2(a[2], a[3]); o0.z = pk2(a[4], a[5]); o0.w = pk2(a[6], a[7]);
            o1.x = pk2(a[8], a[9]); o1.y = pk2(a[10], a[11]); o1.z = pk2(a[12], a[13]); o1.w = pk2(a[14], a[15]);
            qp[0] = o0; qp[1] = o1;
            v4u* rp = (v4u*)(qrow + 128 + s8 * 8);
            const v4u w = rp[0];
            float r[8] = {bflo(w.x), bfhi(w.x), bflo(w.y), bfhi(w.y), bflo(w.z), bfhi(w.z), bflo(w.w), bfhi(w.w)};
            float s2 = 0.f;
#pragma unroll
            for (int j = 0; j < 8; ++j) s2 += r[j] * r[j];
            s2 += sx<1>(s2); s2 += sx<2>(s2); s2 += sx<4>(s2);
            const float rstd2 = 1.0f / sqrtf(s2 * (1.0f / 64.0f) + EPS);
            const int t = row & (SEQ - 1);
#pragma unroll
            for (int j = 0; j < 8; ++j) {
                float y = r[j] * rstd2 * gqr[s8 * 8 + j];
                const float other = sx<2>(y);
                if (row < TX) {
                    const int d = s8 * 8 + j, within = d & 31, i = within & 15;
                    const float pos = (float)((d >> 5) ? (t & 63) : (t >> 6));
                    const float ang = pos * rope_invfreq(i);
                    const float cs = cosf(ang), sn = sinf(ang);
                    y = within < 16 ? y * cs - other * sn : other * sn + y * cs;
                }
                r[j] = y * QSCALE; qq += r[j] * r[j];
            }
            v4u o; o.x = pk2(r[0], r[1]); o.y = pk2(r[2], r[3]); o.z = pk2(r[4], r[5]); o.w = pk2(r[6], r[7]);
            rp[0] = o;
            qq += sx<1>(qq); qq += sx<2>(qq); qq += sx<4>(qq);
            if (s8 == 0) WSP(float, WS_BQ)[(size_t)row * 8 + h] = sqrtf(qq) * kbound;
        }
    }
}

__device__ __forceinline__ int key_row(bool isx, int b, int key) { return isx ? (key < CTXL ? TX + b * CTXL + key : b * SEQ + (key - CTXL)) : TX + b * CTXL + key; }

__device__ __forceinline__ float log2_gamma(const Frame& F, int l, int dir, int h) { const float x = F.in[IN_RDECAY][(l * 2 + dir) * 4 + h]; return -log1pf(expf(-x)) * 1.4426950408889634f; }

__device__ __forceinline__ void ret_naive(const Frame& F, int l) {
    LAS float* dl = (LAS float*)(F.lds + F.wave * 9216);
    const bf16_t* Z = WSP(bf16_t, WS_Z);
    const int nrows = (l == 0) ? TT : TX;
    for (int item = F.gw; item < nrows * 4; item += F.NGW) {
        const int row = item >> 2, h = item & 3; const bool isx = row < TX;
        const int b = isx ? row >> 11 : (row - TX) >> 8, nk = isx ? SEQ + CTXL : CTXL;
        const int tpos = isx ? (row & (SEQ - 1)) : ((row - TX) & (CTXL - 1));
        const v4u* qp = (const v4u*)(Z + (size_t)row * ZLD + ZC_RQ + h * 64);
        for (int i = 0; i < nk / 64; ++i) {
            const int key = i * 64 + F.lane, kr = key_row(isx, b, key);
            const v4u* kp = (const v4u*)(Z + (size_t)kr * ZLD + ZC_RK + h * 64);
            float s = 0.f;
#pragma unroll
            for (int c = 0; c < 8; ++c) s = dot8(qp[c], kp[c], s);
            dl[key] = s * 0.125f;
        }
        LDS_WAIT(); asm volatile("" ::: "memory");
        const float lgf = log2_gamma(F, l, 0, h), lgb = log2_gamma(F, l, 1, h);
        float f0 = 0.f, f1 = 0.f, b0 = 0.f, b1 = 0.f;
        for (int key = 0; key < nk; ++key) {
            const int kr = key_row(isx, b, key);
            const unsigned v2 = *((const unsigned*)(Z + (size_t)kr * ZLD + ZC_RV + h * 128) + F.lane);
            float wf = 0.f, wb = 0.f;
            if (isx) {
                if (key < CTXL) { wf = exp2f((float)(tpos + CTXL - key) * lgf); wb = exp2f((float)(SEQ - tpos + key) * lgb); }
                else { const int s = key - CTXL; if (s <= tpos) wf = exp2f((float)(tpos - s) * lgf); if (s >= tpos) wb = exp2f((float)(s - tpos) * lgb); }
            } else { if (key <= tpos) wf = exp2f((float)(tpos - key) * lgf); if (key >= tpos) wb = exp2f((float)(key - tpos) * lgb); }
            const float d = dl[key]; const float v0 = bflo(v2), v1 = bfhi(v2);
            f0 = fmaf(wf * d, v0, f0); f1 = fmaf(wf * d, v1, f1); b0 = fmaf(wb * d, v0, b0); b1 = fmaf(wb * d, v1, b1);
        }
        float* ro = WSP(float, WS_RO) + (size_t)row * 512 + h * 128 + 2 * F.lane;
        ro[0] = f0; ro[1] = f1; ro[(size_t)TT * 512] = b0; ro[(size_t)TT * 512 + 1] = b1;
        LDS_WAIT(); asm volatile("" ::: "memory");
    }
}

__device__ __forceinline__ void hyena_ctx(const Frame& F, int l) {
    if (l != 0) return;
    LAS float* base = (LAS float*)(F.lds + F.wave * 8192);
    LAS float* sin_ = base; LAS float* sy = base + 256; LAS float* tp = base + 512;
    const bf16_t* ZT = WSP(bf16_t, WS_ZT);
    const float* cw = F.in[IN_HCW]; const float* cb = F.in[IN_HCB]; const float* skip = F.in[IN_HSKIP];
    const int t0 = 4 * F.lane;
    for (int it = F.gw; it < NB * 512; it += F.NGW) {
        const int b = it >> 9, c = it & 511, col0 = TX + b * CTXL;
        float gx1[4], gx2[4], vv[4];
#pragma unroll
        for (int g = 0; g < 3; ++g) { const int j = g * 512 + c; const bf16_t* rp = ZT + (size_t)j * TT + col0;
            const v2u w = *(const v2u*)(rp + t0);
            const float u0 = bflo(w.x), u1 = bfhi(w.x), u2 = bflo(w.y), u3 = bfhi(w.y);
            const float um = t0 > 0 ? bf1(rp[t0 - 1]) : 0.f, up = t0 + 4 < CTXL ? bf1(rp[t0 + 4]) : 0.f;
            const float w0 = cw[j], w1 = cw[1536 + j], w2 = cw[2 * 1536 + j], bs = cb[j];
            float o[4] = {w0 * um + w1 * u0 + w2 * u1 + bs, w0 * u0 + w1 * u1 + w2 * u2 + bs, w0 * u1 + w1 * u2 + w2 * u3 + bs, w0 * u2 + w1 * u3 + w2 * up + bs};
#pragma unroll
            for (int e = 0; e < 4; ++e) { if (g == 0) gx1[e] = o[e]; else if (g == 1) gx2[e] = o[e]; else vv[e] = o[e]; } }
        *(LAS f32x4*)(sin_ + t0) = (f32x4){vv[0], vv[1], vv[2], vv[3]};
#pragma unroll
        for (int o = 0; o < 2; ++o) {
            const float* tg = WSP(float, WS_TAPSC) + ((size_t)o * 512 + c) * 512;
            *(LAS f32x4*)(tp + 8 * F.lane) = *(const f32x4*)(tg + 8 * F.lane); *(LAS f32x4*)(tp + 8 * F.lane + 4) = *(const f32x4*)(tg + 8 * F.lane + 4);
            LDS_WAIT(); asm volatile("" ::: "memory");
            const LAS float* in = o ? sy : sin_; const float sk = skip[o * 512 + c];
            float acc[4] = {0.f, 0.f, 0.f, 0.f};
#pragma unroll 4
            for (int m = 0; m < CTXL / 4; ++m) {
                const f32x4 u = *(const LAS f32x4*)(in + 4 * m);
                const int d0 = (t0 - 4 * m) & 511;
                const f32x4 hi = *(const LAS f32x4*)(tp + d0), lo = *(const LAS f32x4*)(tp + ((d0 - 4) & 511));
                const float w[7] = {lo[1], lo[2], lo[3], hi[0], hi[1], hi[2], hi[3]};
#pragma unroll
                for (int k = 0; k < 4; ++k)
#pragma unroll
                    for (int j = 0; j < 4; ++j) acc[k] = fmaf(w[3 + k - j], u[j], acc[k]);
            }
            const f32x4 iv = *(const LAS f32x4*)(in + t0);
            float y[4];
#pragma unroll
            for (int k = 0; k < 4; ++k) y[k] = (o ? gx2[k] : gx1[k]) * (acc[k] + sk * iv[k]);
            LDS_WAIT(); asm volatile("" ::: "memory");
            if (o == 0) *(LAS f32x4*)(sy + t0) = (f32x4){y[0], y[1], y[2], y[3]};
            else *(f32x4*)(WSP(float, WS_HY) + (size_t)c * TT + col0 + t0) = (f32x4){y[0], y[1], y[2], y[3]};
            LDS_WAIT(); asm volatile("" ::: "memory");
        }
    }
}

__device__ __forceinline__ void merge_phase(const Frame& F, int l) {
    const int nrows = (l == 0) ? TT : TX;
    LAS float* hy_s = (LAS float*)F.lds;
    const float* gout = F.in[IN_OUTNORM] + l * 1024; const float* ghy = F.in[IN_HONORM] + l * 512; const float* gnw = F.in[IN_RGNW] + l * 512; const float* gnb = F.in[IN_RGNB] + l * 512;
    for (int tile = F.bid; tile < nrows / 32; tile += F.G) {
      __syncthreads();
      { const f32x4* hp = (const f32x4*)(WSP(float, WS_HY) + (size_t)F.tid * TT + tile * 32);
#pragma unroll
        for (int q = 0; q < 8; ++q) { const f32x4 v = hp[q];
#pragma unroll
            for (int e = 0; e < 4; ++e) hy_s[F.tid * 33 + 4 * q + e] = v[e]; } }
      __syncthreads();
#pragma unroll
      for (int r4 = 0; r4 < 4; ++r4) {
        const int rr = 4 * F.wave + r4, row = tile * 32 + rr;
        bf16_t* mr = WSP(bf16_t, WS_HMOD) + (size_t)row * DM;
        {
            const v4u* ap = (const v4u*)(WSP(bf16_t, WS_AO) + (size_t)row * 1024 + F.lane * 16);
            const v4u w0 = ap[0], w1 = ap[1];
            float a[16] = {bflo(w0.x), bfhi(w0.x), bflo(w0.y), bfhi(w0.y), bflo(w0.z), bfhi(w0.z), bflo(w0.w), bfhi(w0.w),
                           bflo(w1.x), bfhi(w1.x), bflo(w1.y), bfhi(w1.y), bflo(w1.z), bfhi(w1.z), bflo(w1.w), bfhi(w1.w)};
            float ss = 0.f;
#pragma unroll
            for (int j = 0; j < 16; ++j) ss += a[j] * a[j];
            const float rstd = 1.0f / sqrtf(wave_sum(ss) * (1.0f / 1024.0f) + EPS);
            const float* g = gout + F.lane * 16;
            v4u o0, o1;
            o0.x = pk2(a[0] * rstd * g[0], a[1] * rstd * g[1]); o0.y = pk2(a[2] * rstd * g[2], a[3] * rstd * g[3]); o0.z = pk2(a[4] * rstd * g[4], a[5] * rstd * g[5]); o0.w = pk2(a[6] * rstd * g[6], a[7] * rstd * g[7]);
            o1.x = pk2(a[8] * rstd * g[8], a[9] * rstd * g[9]); o1.y = pk2(a[10] * rstd * g[10], a[11] * rstd * g[11]); o1.z = pk2(a[12] * rstd * g[12], a[13] * rstd * g[13]); o1.w = pk2(a[14] * rstd * g[14], a[15] * rstd * g[15]);
            v4u* op = (v4u*)(mr + F.lane * 16); op[0] = o0; op[1] = o1;
        }
        {
            float a[8]; float ss = 0.f;
#pragma unroll
            for (int j = 0; j < 8; ++j) { a[j] = hy_s[(F.lane + 64 * j) * 33 + rr]; ss += a[j] * a[j]; }
            const float rstd = 1.0f / sqrtf(wave_sum(ss) * (1.0f / 512.0f) + EPS);
#pragma unroll
            for (int j = 0; j < 8; ++j) mr[1024 + F.lane + 64 * j] = (bf16_t)f2bf(a[j] * rstd * ghy[F.lane + 64 * j]);
        }
        {
            const float* r0 = WSP(float, WS_RO) + (size_t)row * 512 + F.lane * 8; const float* r1 = r0 + (size_t)TT * 512;
            const f32x4 x0 = *(const f32x4*)r0 + *(const f32x4*)r1, x1 = *((const f32x4*)r0 + 1) + *((const f32x4*)r1 + 1);
            float a[8] = {x0[0], x0[1], x0[2], x0[3], x1[0], x1[1], x1[2], x1[3]};
            float s = 0.f;
#pragma unroll
            for (int j = 0; j < 8; ++j) s += a[j];
            s += sx<1>(s); s += sx<2>(s); s += sx<4>(s); s += sx<8>(s);
            const float mu = s * (1.0f / 128.0f); float q = 0.f;
#pragma unroll
            for (int j = 0; j < 8; ++j) { a[j] -= mu; q += a[j] * a[j]; }
            q += sx<1>(q); q += sx<2>(q); q += sx<4>(q); q += sx<8>(q);
            const float rstd = 1.0f / sqrtf(q * (1.0f / 128.0f) + EPS);
            const v4u gw = *((const v4u*)(WSP(bf16_t, WS_Z) + (size_t)row * ZLD + ZC_RG) + F.lane);
            const float gt[8] = {bflo(gw.x), bfhi(gw.x), bflo(gw.y), bfhi(gw.y), bflo(gw.z), bfhi(gw.z), bflo(gw.w), bfhi(gw.w)};
            float y[8];
#pragma unroll
            for (int j = 0; j < 8; ++j) { const float o = a[j] * rstd * gnw[F.lane * 8 + j] + gnb[F.lane * 8 + j]; const float gg = gt[j]; y[j] = gg / (1.0f + expf(-gg)) * o; }
            v4u o; o.x = pk2(y[0], y[1]); o.y = pk2(y[2], y[3]); o.z = pk2(y[4], y[5]); o.w = pk2(y[6], y[7]);
            *((v4u*)(mr + 1536) + F.lane) = o;
        }
      }
    }
    __syncthreads();
}

namespace att {
typedef short bf16x8 __attribute__((ext_vector_type(8)));
typedef short s16x4 __attribute__((ext_vector_type(4)));
typedef float f32x16 __attribute__((ext_vector_type(16)));
typedef unsigned u32x4 __attribute__((ext_vector_type(4)));
constexpr int KROW = 400;
constexpr int SHM_K = 64 * KROW, SHM_V = 64 * 128 * 2;
constexpr int OFF_V = 0, OFF_K = 2 * SHM_V, OFF_WS = OFF_K + 2 * SHM_K, ATT_LDS = OFF_WS + 8 * 256;
static_assert(ATT_LDS <= RING_BYTES, "attention LDS");
#define ATT_SBAR() __builtin_amdgcn_sched_barrier(0)
__device__ __forceinline__ int crow(int r, int hi) { return (r & 3) + 8 * (r >> 2) + 4 * hi; }
__device__ __forceinline__ unsigned cvtpk(float lo, float hi) { unsigned r; asm volatile("v_cvt_pk_bf16_f32 %0, %1, %2" : "=v"(r) : "v"(lo), "v"(hi)); return r; }
__device__ __forceinline__ int v_st(int k, int c) { const int kk = (k & ~0xC) | ((k & 4) << 1) | ((k & 8) >> 1); return ((kk >> 3) * 4 + (c >> 5)) * 512 + ((kk & 7) * 32 + (c & 31)) * 2; }
__device__ __forceinline__ int v_rd_base(int lane) { return ((lane & 3) << 3) | (((lane >> 2) & 3) << 6) | (((lane >> 4) & 1) << 5) | (((lane >> 5) & 1) << 8); }
constexpr int v_rd_off(int d0, int ks, int half) { return d0 * 512 + ks * 4096 + half * 2048; }
template <int OFF> __device__ __forceinline__ s16x4 tr_read(int vb) { s16x4 r; asm volatile("ds_read_b64_tr_b16 %0, %1 offset:%2" : "=&v"(r) : "v"(vb), "i"(OFF) : "memory"); return r; }
template <int D0> __device__ __forceinline__ void pv_one(f32x16& od, int vb, bf16x8 pa0, bf16x8 pa1, bf16x8 pa2, bf16x8 pa3) {
    const s16x4 l0 = tr_read<v_rd_off(D0, 0, 0)>(vb), h0 = tr_read<v_rd_off(D0, 0, 1)>(vb), l1 = tr_read<v_rd_off(D0, 1, 0)>(vb), h1 = tr_read<v_rd_off(D0, 1, 1)>(vb);
    const s16x4 l2 = tr_read<v_rd_off(D0, 2, 0)>(vb), h2 = tr_read<v_rd_off(D0, 2, 1)>(vb), l3 = tr_read<v_rd_off(D0, 3, 0)>(vb), h3 = tr_read<v_rd_off(D0, 3, 1)>(vb);
    asm volatile("s_waitcnt lgkmcnt(0)" ::: "memory"); ATT_SBAR();
#define ATT_PK(L, H) (bf16x8){L[0], L[1], L[2], L[3], H[0], H[1], H[2], H[3]}
    od = __builtin_amdgcn_mfma_f32_32x32x16_bf16(pa0, ATT_PK(l0, h0), od, 0, 0, 0);
    od = __builtin_amdgcn_mfma_f32_32x32x16_bf16(pa1, ATT_PK(l1, h1), od, 0, 0, 0);
    od = __builtin_amdgcn_mfma_f32_32x32x16_bf16(pa2, ATT_PK(l2, h2), od, 0, 0, 0);
    od = __builtin_amdgcn_mfma_f32_32x32x16_bf16(pa3, ATT_PK(l3, h3), od, 0, 0, 0);
#undef ATT_PK
}
template <int OFF> __device__ __forceinline__ bf16x8 lds_read128(int addr) { bf16x8 r; asm volatile("ds_read_b128 %0, %1 offset:%2" : "=&v"(r) : "v"(addr), "i"(OFF) : "memory"); return r; }
__device__ __forceinline__ void qkt(f32x16& p0, f32x16& p1, float negB, int kaddr, const bf16x8 (&qr)[12]) {
#pragma unroll
    for (int r = 0; r < 16; ++r) { p0[r] = negB; p1[r] = negB; }
    constexpr int B0 = 0, B1 = 32 * KROW;
    bf16x8 a0[3], a1[3], c0[3], c1[3];
#define ATT_LDG(X0, X1, G) do { X0[0] = lds_read128<B0 + (3 * (G) + 0) * 32>(kaddr); X1[0] = lds_read128<B1 + (3 * (G) + 0) * 32>(kaddr); X0[1] = lds_read128<B0 + (3 * (G) + 1) * 32>(kaddr); \
        X1[1] = lds_read128<B1 + (3 * (G) + 1) * 32>(kaddr); X0[2] = lds_read128<B0 + (3 * (G) + 2) * 32>(kaddr); X1[2] = lds_read128<B1 + (3 * (G) + 2) * 32>(kaddr); } while (0)
#define ATT_MMG(X0, X1, G) do { _Pragma("unroll") for (int i = 0; i < 3; ++i) { p0 = __builtin_amdgcn_mfma_f32_32x32x16_bf16(X0[i], qr[3 * (G) + i], p0, 0, 0, 0); \
        p1 = __builtin_amdgcn_mfma_f32_32x32x16_bf16(X1[i], qr[3 * (G) + i], p1, 0, 0, 0); } } while (0)
    ATT_LDG(a0, a1, 0);
    ATT_LDG(c0, c1, 1); asm volatile("s_waitcnt lgkmcnt(6)" ::: "memory"); ATT_SBAR(); ATT_MMG(a0, a1, 0); ATT_SBAR();
    ATT_LDG(a0, a1, 2); asm volatile("s_waitcnt lgkmcnt(6)" ::: "memory"); ATT_SBAR(); ATT_MMG(c0, c1, 1); ATT_SBAR();
    ATT_LDG(c0, c1, 3); asm volatile("s_waitcnt lgkmcnt(6)" ::: "memory"); ATT_SBAR(); ATT_MMG(a0, a1, 2); ATT_SBAR();
    asm volatile("s_waitcnt lgkmcnt(0)" ::: "memory"); ATT_SBAR(); ATT_MMG(c0, c1, 3); ATT_SBAR();
#undef ATT_LDG
#undef ATT_MMG
}
__device__ __forceinline__ void softmax_pack(f32x16& p0, f32x16& p1, float& l_reg, bf16x8& pa0, bf16x8& pa1, bf16x8& pa2, bf16x8& pa3) {
#pragma unroll
    for (int r = 0; r < 16; ++r) { p0[r] = __builtin_amdgcn_exp2f(p0[r]); p1[r] = __builtin_amdgcn_exp2f(p1[r]); }
    float ps = 0.f;
#pragma unroll
    for (int r = 0; r < 16; ++r) ps += p0[r] + p1[r];
    l_reg += ps;
#define ATT_PK4(P, BASE, OUT) do { unsigned a0 = cvtpk(P[BASE + 0], P[BASE + 1]), a1 = cvtpk(P[BASE + 2], P[BASE + 3]);   \
    unsigned b0 = cvtpk(P[BASE + 4], P[BASE + 5]), b1 = cvtpk(P[BASE + 6], P[BASE + 7]);                              \
    auto r0 = __builtin_amdgcn_permlane32_swap(a0, b0, false, false); auto r1 = __builtin_amdgcn_permlane32_swap(a1, b1, false, false); \
    u32x4 w = {r0[0], r1[0], r0[1], r1[1]}; OUT = *reinterpret_cast<bf16x8*>(&w); } while (0)
    ATT_PK4(p0, 0, pa0); ATT_PK4(p0, 8, pa1); ATT_PK4(p1, 0, pa2); ATT_PK4(p1, 8, pa3);
#undef ATT_PK4
}
__device__ __forceinline__ void v_inv(int x, int& k, int& c) { const int sub = x >> 9, within = x & 511, kk = (sub >> 2) * 8 + (within >> 6); k = (kk & ~0xC) | ((kk & 4) << 1) | ((kk & 8) >> 1); c = (sub & 3) * 32 + ((within & 63) >> 1); }

__device__ __forceinline__ void attn_unit(const bf16_t* Qb, const float* Bq, const bf16_t* KVh, const bf16_t* KR, bf16_t* Ob, int rowc, int rowx, int NT, LAS char* lds, int tid_in) {
    int tid = tid_in; asm volatile("" : "+v"(tid));
    const int wid = __builtin_amdgcn_readfirstlane(tid >> 6), lane = tid & 63, r32 = lane & 31, hi = lane >> 5;
    LAS float* li_l = (LAS float*)(lds + OFF_WS + wid * 256);
    float l_reg = 0.f; f32x16 o[4];
#pragma unroll
    for (int d = 0; d < 4; ++d)
#pragma unroll
        for (int r = 0; r < 16; ++r) o[d][r] = 0.f;
    bf16x8 qr[12];
    { const bf16_t* Qw = Qb + (size_t)(wid * 32 + r32) * 1536 + hi * 8;
#pragma unroll
      for (int d0 = 0; d0 < 12; ++d0) qr[d0] = *(const bf16x8*)(Qw + d0 * 16); }
    const float negB = -Bq[(wid * 32 + r32) * 8];
    unsigned vsrc[2], ksrc[4]; bool krope[4];
#pragma unroll
    for (int i = 0; i < 2; ++i) { int k, c; v_inv((wid * 2 + i) * 1024 + lane * 16, k, c); vsrc[i] = (unsigned)(k * 4096 + (128 + c) * 2); }
#pragma unroll
    for (int i = 0; i < 4; ++i) { const int x = (wid + 8 * i) * 1024 + lane * 16, row = x / KROW, cb = x % KROW;
        krope[i] = (cb >= 256 && cb < 384); ksrc[i] = krope[i] ? (unsigned)(row * 128 + (cb - 256)) : (unsigned)(row * 4096 + (cb < 256 ? cb : 0)); }
    const int kaddr = (int)(unsigned)(size_t)lds + OFF_K + r32 * KROW + hi * 16;
    const int vb0 = (int)(unsigned)(size_t)lds + OFF_V + v_rd_base(lane);
#define ATT_ISSUE(BUF, t) do { const int row0_ = (t) < 4 ? rowc + 64 * (t) : rowx + 64 * ((t) - 4); \
        const char* kvb_ = (const char*)KVh + (size_t)row0_ * 4096; const char* krb_ = (const char*)KR + (size_t)row0_ * 128; \
        _Pragma("unroll") for (int i_ = 0; i_ < 2; ++i_) __builtin_amdgcn_global_load_lds((const unsigned*)(kvb_ + vsrc[i_]), (LAS unsigned*)(lds + OFF_V + (BUF) * SHM_V + (wid * 2 + i_) * 1024), 16, 0, 0); \
        _Pragma("unroll") for (int i_ = 0; i_ < 3; ++i_) __builtin_amdgcn_global_load_lds((const unsigned*)((krope[i_] ? krb_ : kvb_) + ksrc[i_]), (LAS unsigned*)(lds + OFF_K + (BUF) * SHM_K + (wid + 8 * i_) * 1024), 16, 0, 0); \
        if (wid == 0) __builtin_amdgcn_global_load_lds((const unsigned*)((krope[3] ? krb_ : kvb_) + ksrc[3]), (LAS unsigned*)(lds + OFF_K + (BUF) * SHM_K + 24 * 1024), 16, 0, 0); } while (0)
#define ATT_TILE_DONE() do { asm volatile("s_waitcnt vmcnt(0)" ::: "memory"); __builtin_amdgcn_s_barrier(); asm volatile("" ::: "memory"); } while (0)
    f32x16 p0, p1; bf16x8 pa0, pa1, pa2, pa3;
    ATT_ISSUE(0, 0); ATT_TILE_DONE();
    for (int j = 0; j < NT; j += 2) {
        ATT_ISSUE(1, j + 1);
        ATT_SBAR(); qkt(p0, p1, negB, kaddr, qr);
        softmax_pack(p0, p1, l_reg, pa0, pa1, pa2, pa3); ATT_SBAR();
        pv_one<0>(o[0], vb0, pa0, pa1, pa2, pa3); pv_one<1>(o[1], vb0, pa0, pa1, pa2, pa3); pv_one<2>(o[2], vb0, pa0, pa1, pa2, pa3); pv_one<3>(o[3], vb0, pa0, pa1, pa2, pa3);
        ATT_TILE_DONE();
        if (j + 2 < NT) ATT_ISSUE(0, j + 2);
        ATT_SBAR(); qkt(p0, p1, negB, kaddr + SHM_K, qr);
        softmax_pack(p0, p1, l_reg, pa0, pa1, pa2, pa3); ATT_SBAR();
        pv_one<0>(o[0], vb0 + SHM_V, pa0, pa1, pa2, pa3); pv_one<1>(o[1], vb0 + SHM_V, pa0, pa1, pa2, pa3); pv_one<2>(o[2], vb0 + SHM_V, pa0, pa1, pa2, pa3); pv_one<3>(o[3], vb0 + SHM_V, pa0, pa1, pa2, pa3);
        ATT_TILE_DONE();
    }
#undef ATT_ISSUE
#undef ATT_TILE_DONE
    li_l[lane] = l_reg;
    asm volatile("s_waitcnt lgkmcnt(0)" ::: "memory");
    int lane2 = lane; asm volatile("" : "+v"(lane2));
    const int r32e = lane2 & 31, hie = lane2 >> 5;
    LAS char* st = lds + wid * (32 * 272);
#pragma unroll
    for (int r = 0; r < 16; ++r) { const int orow = (r & 3) + 8 * (r >> 2); const float rl = __builtin_amdgcn_rcpf(li_l[orow + 4 * hie] + li_l[32 + orow + 4 * hie]);
#pragma unroll
        for (int d0 = 0; d0 < 4; ++d0) *(LAS bf16_t*)(st + (orow + 4 * hie) * 272 + (d0 * 32 + r32e) * 2) = (bf16_t)f2bf(o[d0][r] * rl); }
    asm volatile("s_waitcnt lgkmcnt(0)" ::: "memory");
    bf16_t* Ow = Ob + (size_t)(wid * 32) * 1024;
#pragma unroll
    for (int k = 0; k < 8; ++k) { const int p = lane2 + 64 * k, prow = p >> 4, pc = p & 15;
        const u32x4 v = *(const LAS u32x4*)(st + prow * 272 + pc * 16);
        *(u32x4*)(Ow + (size_t)prow * 1024 + pc * 8) = v; }
    asm volatile("s_waitcnt lgkmcnt(0)" ::: "memory");
}
}

__device__ __forceinline__ void attn_phase(const Frame& F, int l) {
    const int nitems = (l == 0) ? 512 + 64 : 512;
    const int vcu = (F.G % 8 == 0) ? (F.bid % 8) * (F.G / 8) + F.bid / 8 : F.bid;
    const bf16_t* Q = WSP(bf16_t, WS_Q); const bf16_t* KV = WSP(bf16_t, WS_KV); const bf16_t* KR = WSP(bf16_t, WS_KROPE); const float* BQ = WSP(float, WS_BQ); bf16_t* AO = WSP(bf16_t, WS_AO);
    for (int item = vcu; item < nitems; item += F.G) {
        int b, h, row0, NT;
        if (item < 512) { const int bh = item >> 3, qb = item & 7; b = bh >> 3; h = bh & 7; row0 = b * SEQ + qb * 256; NT = (SEQ + CTXL) / 64; }
        else { const int bh = item - 512; b = bh >> 3; h = bh & 7; row0 = TX + b * CTXL; NT = CTXL / 64; }
        __syncthreads();
        att::attn_unit(Q + (size_t)row0 * 1536 + h * 192, BQ + (size_t)row0 * 8 + h, KV + h * 256, KR, AO + (size_t)row0 * 1024 + h * 128, TX + b * CTXL, b * SEQ, NT, (LAS char*)F.lds, F.tid);
    }
    __syncthreads();
}

namespace ret {
typedef short bf16x8 __attribute__((ext_vector_type(8)));
typedef float f32x4 __attribute__((ext_vector_type(4)));
constexpr int QS = 144, TS = 272;
constexpr int OFF_Q = 0, OFF_K = OFF_Q + 128 * QS, OFF_KT = OFF_K + 128 * QS, OFF_VT = OFF_KT + 64 * TS, OFF_A = OFF_VT + 32 * TS, OFF_ST = OFF_A + 128 * TS, RET_LDS = OFF_ST + 32 * QS;
static_assert(RET_LDS <= RING_BYTES, "retention LDS");
__device__ __forceinline__ bf16x8 ldsv(const LAS char* p) { return *(const LAS bf16x8*)p; }

__device__ __forceinline__ void ret_item(const Frame& F, int l, int b, int h, int dir, int dvq) {
    LAS char* lds = (LAS char*)F.lds;
    int tid = F.tid; asm volatile("" : "+v"(tid));
    const int w = __builtin_amdgcn_readfirstlane(tid >> 6), lane = tid & 63, lr = lane & 15, g = lane >> 4;
    const bf16_t* Z = WSP(bf16_t, WS_Z);
    const float lg2 = log2_gamma(F, l, dir, h);
    const float cd = __builtin_amdgcn_exp2f(128.0f * lg2);
    f32x4 S = {0.f, 0.f, 0.f, 0.f};
    const int qrow0 = tid & 63, qc8 = tid >> 6, vrow = tid & 127, vc4 = tid >> 7;
    v4u rq[2], rk[2], rv;
#define RET_ROW0(p) ((p) < 2 ? TX + b * CTXL + 128 * (dir ? 1 - (p) : (p)) : b * SEQ + 128 * (dir ? 17 - (p) : (p) - 2))
#define RET_LOAD(p) do { const int r0_ = RET_ROW0(p); \
        _Pragma("unroll") for (int k_ = 0; k_ < 2; ++k_) { const bf16_t* zr_ = Z + (size_t)(r0_ + qrow0 + 64 * k_) * ZLD + h * 64 + qc8 * 8; rq[k_] = *(const v4u*)(zr_ + ZC_RQ); rk[k_] = *(const v4u*)(zr_ + ZC_RK); } \
        rv = *(const v4u*)(Z + (size_t)(r0_ + vrow) * ZLD + ZC_RV + h * 128 + dvq * 32 + vc4 * 8); } while (0)
#define RET_STORE() do { \
        _Pragma("unroll") for (int k_ = 0; k_ < 2; ++k_) { const int row_ = qrow0 + 64 * k_; const int e_ = dir ? 127 - row_ : row_; const float kd_ = 0.125f * __builtin_amdgcn_exp2f((float)(127 - e_) * lg2); \
            *(LAS v4u*)(lds + OFF_Q + row_ * QS + qc8 * 16) = rq[k_]; \
            const unsigned kw_[4] = {rk[k_].x, rk[k_].y, rk[k_].z, rk[k_].w}; v4u ks_; unsigned* ksp_ = (unsigned*)&ks_; \
            _Pragma("unroll") for (int q_ = 0; q_ < 4; ++q_) { const float lo_ = bflo(kw_[q_]), hi_ = bfhi(kw_[q_]); ksp_[q_] = pk2(lo_ * 0.125f, hi_ * 0.125f); \
                *(LAS bf16_t*)(lds + OFF_KT + (qc8 * 8 + 2 * q_) * TS + row_ * 2) = (bf16_t)f2bf(lo_ * kd_); *(LAS bf16_t*)(lds + OFF_KT + (qc8 * 8 + 2 * q_ + 1) * TS + row_ * 2) = (bf16_t)f2bf(hi_ * kd_); } \
            *(LAS v4u*)(lds + OFF_K + row_ * QS + qc8 * 16) = ks_; } \
        { const unsigned vw_[4] = {rv.x, rv.y, rv.z, rv.w}; \
          _Pragma("unroll") for (int q_ = 0; q_ < 4; ++q_) { *(LAS bf16_t*)(lds + OFF_VT + (vc4 * 8 + 2 * q_) * TS + vrow * 2) = (bf16_t)(vw_[q_] & 0xffffu); *(LAS bf16_t*)(lds + OFF_VT + (vc4 * 8 + 2 * q_ + 1) * TS + vrow * 2) = (bf16_t)(vw_[q_] >> 16); } } } while (0)
    __syncthreads();
    RET_LOAD(0); RET_STORE();
    { unsigned z0; asm volatile("v_mov_b32 %0, 0" : "=v"(z0));
      if (tid < 288) *(LAS unsigned*)(lds + OFF_ST + tid * 16) = z0, *(LAS unsigned*)(lds + OFF_ST + tid * 16 + 4) = z0, *(LAS unsigned*)(lds + OFF_ST + tid * 16 + 8) = z0, *(LAS unsigned*)(lds + OFF_ST + tid * 16 + 12) = z0; }
    __syncthreads();
    for (int p = 0; p < 18; ++p) {
        if (p + 1 < 18) RET_LOAD(p + 1);
        const bool want_out = (p >= 2) || (l == 0);
        if (want_out) {
            bf16x8 qf[2];
#pragma unroll
            for (int ks = 0; ks < 2; ++ks) qf[ks] = ldsv(lds + OFF_Q + (16 * w + lr) * QS + ks * 64 + g * 16);
            const int i = 16 * w + lr, ei = dir ? 127 - i : i;
#pragma unroll
            for (int ct = 0; ct < 8; ++ct) {
                f32x4 a = {0.f, 0.f, 0.f, 0.f};
#pragma unroll
                for (int ks = 0; ks < 2; ++ks) a = __builtin_amdgcn_mfma_f32_16x16x32_bf16(ldsv(lds + OFF_K + (16 * ct + lr) * QS + ks * 64 + g * 16), qf[ks], a, 0, 0, 0);
                float m[4];
#pragma unroll
                for (int r = 0; r < 4; ++r) { const int j = 16 * ct + 4 * g + r, ej = dir ? 127 - j : j; m[r] = ei >= ej ? a[r] * __builtin_amdgcn_exp2f((float)(ei - ej) * lg2) : 0.f; }
                v2u wv; wv.x = pk2(m[0], m[1]); wv.y = pk2(m[2], m[3]);
                *(LAS v2u*)(lds + OFF_A + i * TS + (16 * ct + 4 * g) * 2) = wv;
            }
            f32x4 oc[2];
#pragma unroll
            for (int nt = 0; nt < 2; ++nt) { oc[nt] = (f32x4){0.f, 0.f, 0.f, 0.f};
#pragma unroll
                for (int ks = 0; ks < 2; ++ks) oc[nt] = __builtin_amdgcn_mfma_f32_16x16x32_bf16(qf[ks], ldsv(lds + OFF_ST + (16 * nt + lr) * QS + ks * 64 + g * 16), oc[nt], 0, 0, 0); }
#pragma unroll
            for (int r = 0; r < 4; ++r) { const int i2 = 16 * w + 4 * g + r, e2 = dir ? 127 - i2 : i2; const float qd = __builtin_amdgcn_exp2f((float)(e2 + 1) * lg2); oc[0][r] *= qd; oc[1][r] *= qd; }
            LDS_WAIT(); asm volatile("" ::: "memory");
#pragma unroll
            for (int ks = 0; ks < 4; ++ks) { const bf16x8 af = ldsv(lds + OFF_A + (16 * w + lr) * TS + ks * 64 + g * 16);
#pragma unroll
                for (int nt = 0; nt < 2; ++nt) oc[nt] = __builtin_amdgcn_mfma_f32_16x16x32_bf16(af, ldsv(lds + OFF_VT + (16 * nt + lr) * TS + ks * 64 + g * 16), oc[nt], 0, 0, 0); }
            float* ro = WSP(float, WS_RO) + (size_t)dir * TT * 512 + (size_t)(RET_ROW0(p) + 16 * w + 4 * g) * 512 + h * 128 + dvq * 32 + lr;
#pragma unroll
            for (int r = 0; r < 4; ++r) { ro[r * 512] = oc[0][r]; ro[r * 512 + 16] = oc[1][r]; }
        }
        S = S * cd;
#pragma unroll
        for (int ks = 0; ks < 4; ++ks) S = __builtin_amdgcn_mfma_f32_16x16x32_bf16(ldsv(lds + OFF_KT + (16 * (w >> 1) + lr) * TS + ks * 64 + g * 16), ldsv(lds + OFF_VT + (16 * (w & 1) + lr) * TS + ks * 64 + g * 16), S, 0, 0, 0);
        __syncthreads();
        { v2u sv; sv.x = pk2(S[0], S[1]); sv.y = pk2(S[2], S[3]); *(LAS v2u*)(lds + OFF_ST + (16 * (w & 1) + lr) * QS + (16 * (w >> 1) + 4 * g) * 2) = sv; }
        if (p + 1 < 18) RET_STORE();
        __syncthreads();
    }
#undef RET_ROW0
#undef RET_LOAD
#undef RET_STORE
}
}

__device__ __forceinline__ void ret_phase(const Frame& F, int l) {
    for (int item = F.bid; item < 256; item += F.G) { const int dvq = item & 3, dir = (item >> 2) & 1, h = (item >> 3) & 3, b = item >> 5; ret::ret_item(F, l, b, h, dir, dvq); }
    __syncthreads();
}

namespace hy {
#define HY_LDS LAS
#define HY_FN __device__ __forceinline__
#define HY_CPX_VEC 1
#ifdef HY_CPX_VEC
typedef float cpx __attribute__((ext_vector_type(2)));
#else
struct cpx { float x, y; };
#endif
HY_FN cpx cmul(cpx a, cpx b) { cpx r; r.x = a.x * b.x - a.y * b.y; r.y = a.x * b.y + a.y * b.x; return r; }
HY_FN cpx cadd(cpx a, cpx b) { cpx r; r.x = a.x + b.x; r.y = a.y + b.y; return r; }
HY_FN cpx csub(cpx a, cpx b) { cpx r; r.x = a.x - b.x; r.y = a.y - b.y; return r; }
HY_FN cpx cmuli_neg(cpx a) { cpx r; r.x = a.y; r.y = -a.x; return r; }
HY_FN void dft8(cpx (&v)[8]) {
    const float R = 0.70710678118654752f;
    cpx a0 = cadd(v[0], v[4]), a1 = cadd(v[1], v[5]), a2 = cadd(v[2], v[6]), a3 = cadd(v[3], v[7]);
    cpx b0 = csub(v[0], v[4]), b1 = csub(v[1], v[5]), b2 = csub(v[2], v[6]), b3 = csub(v[3], v[7]);
    { cpx t; t.x = (b1.x + b1.y) * R; t.y = (b1.y - b1.x) * R; b1 = t; }
    b2 = cmuli_neg(b2);
    { cpx t; t.x = (b3.y - b3.x) * R; t.y = -(b3.x + b3.y) * R; b3 = t; }
    { cpx s0 = cadd(a0, a2), s1 = csub(a0, a2), s2 = cadd(a1, a3), s3 = cmuli_neg(csub(a1, a3));
      v[0] = cadd(s0, s2); v[2] = cadd(s1, s3); v[4] = csub(s0, s2); v[6] = csub(s1, s3); }
    { cpx s0 = cadd(b0, b2), s1 = csub(b0, b2), s2 = cadd(b1, b3), s3 = cmuli_neg(csub(b1, b3));
      v[1] = cadd(s0, s2); v[3] = cadd(s1, s3); v[5] = csub(s0, s2); v[7] = csub(s1, s3); }
}
HY_FN cpx hlook(const HY_LDS cpx* Hh, int f) { if (f <= 2048) return Hh[f]; cpx h = Hh[4096 - f]; h.y = -h.y; return h; }
HY_FN int hpad(int i) { return i + (i >> 3); }
template <bool MULH> HY_FN void fft_pass_read(const HY_LDS cpx* X, const HY_LDS cpx* TW, const HY_LDS cpx* Hh, int j, int Ns, cpx (&v)[8]) {
#pragma unroll
    for (int t = 0; t < 8; ++t) { v[t] = X[hpad(j + 512 * t)]; if (MULH) { cpx r = cmul(v[t], hlook(Hh, j + 512 * t)); r.y = -r.y; v[t] = r; } }
    if (Ns > 1) {
        const int k = j & (Ns - 1);
        const cpx w1 = TW[k * (512 / Ns)];
        const cpx w2 = cmul(w1, w1), w3 = cmul(w2, w1), w4 = cmul(w2, w2), w5 = cmul(w4, w1), w6 = cmul(w3, w3), w7 = cmul(w4, w3);
        v[1] = cmul(v[1], w1); v[2] = cmul(v[2], w2); v[3] = cmul(v[3], w3); v[4] = cmul(v[4], w4); v[5] = cmul(v[5], w5); v[6] = cmul(v[6], w6); v[7] = cmul(v[7], w7);
    }
    dft8(v);
}
HY_FN void fft_pass_write(HY_LDS cpx* X, int j, int Ns, const cpx (&v)[8]) {
    const int k = j & (Ns - 1), j0 = ((j - k) << 3) + k;
#pragma unroll
    for (int u = 0; u < 8; ++u) X[hpad(j0 + u * Ns)] = v[u];
}

#undef HY_LDS
#undef HY_FN
constexpr int XBYTES = 4608 * 8;
constexpr int OFF_XA = 0, OFF_XB = XBYTES, OFF_H0 = 2 * XBYTES, OFF_H1 = OFF_H0 + 16400, OFF_TW = OFF_H1 + 16400, HY_LDS_BYTES = OFF_TW + 4096;
static_assert(HY_LDS_BYTES <= RING_BYTES, "hyena LDS");
template <bool MULH> __device__ __forceinline__ void fft4096(LAS cpx* A, LAS cpx* B, const LAS cpx* TW, const LAS cpx* Hh, int j) {
    cpx v[8];
    fft_pass_read<MULH>(A, TW, Hh, j, 1, v); fft_pass_write(B, j, 1, v); __syncthreads();
    fft_pass_read<false>(B, TW, Hh, j, 8, v); fft_pass_write(A, j, 8, v); __syncthreads();
    fft_pass_read<false>(A, TW, Hh, j, 64, v); fft_pass_write(B, j, 64, v); __syncthreads();
    fft_pass_read<false>(B, TW, Hh, j, 512, v); fft_pass_write(A, j, 512, v); __syncthreads();
}
__device__ __forceinline__ void sconv4(const bf16_t* rp, int t0, float w0, float w1, float w2, float bias, float (&o)[4]) {
    const v2u w = *(const v2u*)(rp + t0);
    const float u0 = bflo(w.x), u1 = bfhi(w.x), u2 = bflo(w.y), u3 = bfhi(w.y);
    const float um = t0 > 0 ? bf1(rp[t0 - 1]) : 0.f, up = t0 + 4 < SEQ ? bf1(rp[t0 + 4]) : 0.f;
    o[0] = w0 * um + w1 * u0 + w2 * u1 + bias; o[1] = w0 * u0 + w1 * u1 + w2 * u2 + bias; o[2] = w0 * u1 + w1 * u2 + w2 * u3 + bias; o[3] = w0 * u2 + w1 * u3 + w2 * up + bias;
}
__device__ __forceinline__ void hy_item(const Frame& F, int l, int c) {
    LAS char* lds = (LAS char*)F.lds;
    int tid = F.tid; asm volatile("" : "+v"(tid));
    LAS cpx* XA = (LAS cpx*)(lds + OFF_XA); LAS cpx* XB = (LAS cpx*)(lds + OFF_XB); LAS cpx* H0 = (LAS cpx*)(lds + OFF_H0); LAS cpx* H1 = (LAS cpx*)(lds + OFF_H1); LAS cpx* TW = (LAS cpx*)(lds + OFF_TW);
    const bf16_t* ZT = WSP(bf16_t, WS_ZT);
    const float* cw = F.in[IN_HCW] + (size_t)l * 3 * 1536; const float* cb = F.in[IN_HCB] + (size_t)l * 1536; const float* skip = F.in[IN_HSKIP] + (size_t)l * 2 * 512;
    __syncthreads();
    { float sn, cs; sincosf(6.2831853071795864f * (float)tid * (1.0f / 4096.0f), &sn, &cs); cpx t; t.x = cs; t.y = -sn; TW[tid] = t; }
    {
        const float* t0p = WSP(float, WS_TAPS) + (((size_t)l * 2 + 0) * 512 + c) * 4096 + 8 * tid; const float* t1p = t0p + (size_t)512 * 4096;
        const f32x4 a0 = *(const f32x4*)t0p, a1 = *((const f32x4*)t0p + 1), b0 = *(const f32x4*)t1p, b1 = *((const f32x4*)t1p + 1);
#pragma unroll
        for (int i = 0; i < 4; ++i) { cpx z; z.x = a0[i]; z.y = b0[i]; XA[9 * tid + i] = z; z.x = a1[i]; z.y = b1[i]; XA[9 * tid + 4 + i] = z; }
    }
    __syncthreads();
    fft4096<false>(XA, XB, TW, H0, tid);
    { const float sk0 = skip[c], sk1 = skip[512 + c], sc = 1.0f / 4096.0f;
      for (int f = tid; f <= 2048; f += NTHR) { const cpx zf = XA[hpad(f)], zn = XA[hpad((4096 - f) & 4095)]; cpx h;
          h.x = (0.5f * (zf.x + zn.x) + sk0) * sc; h.y = 0.5f * (zf.y - zn.y) * sc; H0[f] = h;
          h.x = (0.5f * (zf.y + zn.y) + sk1) * sc; h.y = -0.5f * (zf.x - zn.x) * sc; H1[f] = h; } }
    const int t0 = 4 * tid, p0 = t0 + (t0 >> 3), p1 = p0 + 2304;
    const float wx1[4] = {cw[c], cw[1536 + c], cw[3072 + c], cb[c]}, wx2[4] = {cw[512 + c], cw[1536 + 512 + c], cw[3072 + 512 + c], cb[512 + c]}, wv[4] = {cw[1024 + c], cw[1536 + 1024 + c], cw[3072 + 1024 + c], cb[1024 + c]};
    for (int q = 0; q < 4; ++q) {
        __syncthreads();
        float va[4], vb[4];
        sconv4(ZT + (size_t)(1024 + c) * TT + (2 * q) * SEQ, t0, wv[0], wv[1], wv[2], wv[3], va);
        sconv4(ZT + (size_t)(1024 + c) * TT + (2 * q + 1) * SEQ, t0, wv[0], wv[1], wv[2], wv[3], vb);
#pragma unroll
        for (int i = 0; i < 4; ++i) { cpx z; z.x = va[i]; z.y = vb[i]; XA[p0 + i] = z; z.x = 0.f; z.y = 0.f; XA[p1 + i] = z; }
        __syncthreads();
        fft4096<false>(XA, XB, TW, H0, tid); fft4096<true>(XA, XB, TW, H0, tid);
        {
            float ga[4], gb[4];
            sconv4(ZT + (size_t)c * TT + (2 * q) * SEQ, t0, wx1[0], wx1[1], wx1[2], wx1[3], ga);
            sconv4(ZT + (size_t)c * TT + (2 * q + 1) * SEQ, t0, wx1[0], wx1[1], wx1[2], wx1[3], gb);
#pragma unroll
            for (int i = 0; i < 4; ++i) { const cpx y = XA[p0 + i]; cpx z; z.x = ga[i] * y.x; z.y = gb[i] * (-y.y); XA[p0 + i] = z; z.x = 0.f; z.y = 0.f; XA[p1 + i] = z; }
        }
        __syncthreads();
        fft4096<false>(XA, XB, TW, H1, tid); fft4096<true>(XA, XB, TW, H1, tid);
        {   float ga[4], gb[4];
            sconv4(ZT + (size_t)(512 + c) * TT + (2 * q) * SEQ, t0, wx2[0], wx2[1], wx2[2], wx2[3], ga);
            sconv4(ZT + (size_t)(512 + c) * TT + (2 * q + 1) * SEQ, t0, wx2[0], wx2[1], wx2[2], wx2[3], gb);
            f32x4 oa, ob;
#pragma unroll
            for (int i = 0; i < 4; ++i) { const cpx y = XA[p0 + i]; oa[i] = ga[i] * y.x; ob[i] = gb[i] * (-y.y); }
            float* hp = WSP(float, WS_HY) + (size_t)c * TT + (2 * q) * SEQ + t0;
            *(f32x4*)hp = oa; *(f32x4*)(hp + SEQ) = ob;
        }
    }
    __syncthreads();
}
}

__device__ __forceinline__ void hyena_phase(const Frame& F, int l) {
    for (int c = F.bid; c < 512; c += F.G) hy::hy_item(F, l, c);
    __syncthreads();
}

#define PG8_ALIGN true
#define PG8_SP2 true
__device__ __forceinline__ bool rebase(Frame& F, const Args& args) {
    size_t zz = 0; asm volatile("s_mov_b64 %0, 0" : "=s"(zz)); F.in = args.in + zz; F.ws = args.ws + zz; F.out = args.out + zz;
    int wv = F.wave0; asm volatile("" : "+s"(wv));
    int ln; asm volatile("v_mbcnt_lo_u32_b32 %0, -1, 0\n\tv_mbcnt_hi_u32_b32 %0, -1, %0" : "=v"(ln)); int t = wv * 64 + ln; int g = gridDim.x, b = blockIdx.x; asm volatile("" : "+s"(g), "+s"(b));
    F.tid = t; F.lane = t & 63; F.wave = __builtin_amdgcn_readfirstlane(t >> 6); F.G = g; F.bid = b; F.gw = b * NWAVES + F.wave; F.NGW = g * NWAVES;
    return true;
}
template <class Epi>
__device__ __forceinline__ void run_gemm(const Frame& F, const bf16_t* A, const bf16_t* Bt, int M, int N, int K, const Epi& E) {
    pg8::Gemm g{A, Bt, M, N, K, K}; pg8::StaticOrder S; S.init(M, N, F.G, F.bid);
    pg8::gemm_phase<Epi, pg8::StaticOrder, PG8_ALIGN, PG8_SP2>(F.lds, g, S, E, F.tid);
}

__device__ __forceinline__ void run_down(const Frame& F, const bf16_t* Gbuf, const bf16_t* Wd, const float* resx, float* outx, const float* gate) {
    { pg8::EpiResid E{resx, resx, outx, outx, gate, 0.5f}; run_gemm(F, Gbuf, Wd, TX, DM, FF, E); }
    { pg8::Gemm g{Gbuf + (size_t)TX * FF, Wd, TC, DM, FF / 4, FF}; pg8::SplitKOrder S{F.G, F.bid, 4, FF / 4}; pg8::EpiPartial E{WSP(float, WS_PART), (FF / 4) * 2};
      pg8::gemm_phase<pg8::EpiPartial, pg8::SplitKOrder, PG8_ALIGN, PG8_SP2>(F.lds, g, S, E, F.tid); }
}

__global__ void __launch_bounds__(NTHR, 2) fwd_kernel(Args args) {
    extern __shared__ __attribute__((aligned(16))) unsigned char lds_raw[];
    Frame F;
    F.lds = (LAS unsigned char*)lds_raw;
    F.tid = threadIdx.x; F.lane = F.tid & 63; F.wave = __builtin_amdgcn_readfirstlane(F.tid >> 6); F.wave0 = F.wave;
    F.G = gridDim.x; F.bid = blockIdx.x; F.gw = blockIdx.x * NWAVES + F.wave; F.NGW = F.G * NWAVES;
    F.in = args.in; F.ws = args.ws; F.out = args.out;
    volatile LAS unsigned* MISC = (volatile LAS unsigned*)(F.lds + MISC_OFF);
    for (int u = F.tid; u < (LDS_BYTES - LDSCTL_OFF) / 4; u += NTHR) ((LAS unsigned*)(F.lds + LDSCTL_OFF))[u] = 0u;
    __syncthreads();
    const int lo = args.ph_lo, hi = args.ph_hi;
    const bool multi = (hi - lo) > 1; const int bsel = args.bar_sel;
    XcdBarrier bar; bar.bar = (unsigned*)(F.ws + WS_CTL) + CW_BAR + args.bar_sel * XCD_BAR_WORDS; bar.x = 0; bar.st = nullptr;
    if (multi) bar = xcd_barrier_post((unsigned*)(F.ws + WS_CTL) + CW_BAR + args.bar_sel * XCD_BAR_WORDS, MISC + 8, F.tid);
#define IN(k) (lo <= (k) && (k) < hi && rebase(F, args))
#define SEAM(k) do { if (lo <= (k) && (k) + 1 < hi && rebase(F, args)) { XcdBarrier b_ = bar; b_.bar = (unsigned*)(F.ws + WS_CTL) + CW_BAR + bsel * XCD_BAR_WORDS; xcd_barrier(b_, F.tid); } } while (0)

    if (IN(0)) { p0_modpart(F); p0_hyh2(F); p0_weights(F); } SEAM(0);

    for (int l = 0; l < 2; ++l) {
        const int pb = 2 + l * NPH_L;
#define wl (F.ws + WS_W + (size_t)l * LW)
#define modl (WSP(float, WS_MOD) + (size_t)l * 9 * NMODC)
#define xres WSP(float, WS_XRES)
#define xresc (WSP(float, WS_XRES) + (size_t)TX * DM)
#define srcx (l == 0 ? F.in[IN_X] : (const float*)xres)
#define srcc (l == 0 ? F.in[IN_CTX] : (const float*)xresc)
        const int Mmix = (l == 0) ? TT : TX;

        if (IN(pb + 0)) { norm_phase(F, srcx, srcc, TT, modl, 0, 1, WSP(bf16_t, WS_HMOD), l == 0 ? nullptr : WSP(float, WS_PART), WSP(float, WS_MOD) + 8 * NMODC + 8 * DM, xresc); if (l == 0) p1_taps(F); }
        SEAM(pb + 0);
        if (IN(pb + 1)) { pg8::EpiSwiGLU E{WSP(bf16_t, WS_G), FF}; run_gemm(F, WSP(bf16_t, WS_HMOD), (const bf16_t*)(wl + LW_GU1), TT, 2 * FF, DM, E); }
        SEAM(pb + 1);
        if (IN(pb + 2)) run_down(F, WSP(bf16_t, WS_G), (const bf16_t*)(wl + LW_D1), srcx, xres, modl + 2 * DM);
        SEAM(pb + 2);
        if (IN(pb + 3)) norm_phase(F, xres, srcc, TT, modl, 3, 4, WSP(bf16_t, WS_HMOD), WSP(float, WS_PART), modl + 8 * NMODC + 2 * DM, xresc);
        SEAM(pb + 3);
        if (IN(pb + 4)) {
            { pg8::EpiBf16 E{WSP(bf16_t, WS_Z), ZLD}; run_gemm(F, WSP(bf16_t, WS_HMOD), (const bf16_t*)(wl + LW_WINM), TT, ZLD, DM, E); }
            { pg8::EpiBf16 E{WSP(bf16_t, WS_ZT), TT}; run_gemm(F, (const bf16_t*)(wl + LW_WINH), WSP(bf16_t, WS_HMOD), 1536, TT, DM, E); }
        }
        SEAM(pb + 4);
        if (IN(pb + 5)) postproj_phase(F, l);
        SEAM(pb + 5);
        if (IN(pb + 6)) {
            { pg8::EpiBf16 E{WSP(bf16_t, WS_KV), 2048}; run_gemm(F, WSP(bf16_t, WS_KVN), (const bf16_t*)(wl + LW_WUKV), TT, 2048, 256, E); }
            { pg8::EpiBf16 E{WSP(bf16_t, WS_Q), 1536}; run_gemm(F, WSP(bf16_t, WS_QN), (const bf16_t*)(wl + LW_WUQ), Mmix, 1536, 512, E); }
        }
        SEAM(pb + 6);
        if (IN(pb + 7)) headnorm_phase(F, l);
        SEAM(pb + 7);
        if (IN(pb + 8)) { const int mm = args.pad; if (mm & 1) attn_phase(F, l); rebase(F, args); if (mm & 2) ret_phase(F, l); rebase(F, args); if (mm & 4) hyena_phase(F, l); rebase(F, args); if (mm & 8) hyena_ctx(F, l); }
        SEAM(pb + 8);
        if (IN(pb + 9)) merge_phase(F, l);
        SEAM(pb + 9);
        if (IN(pb + 10)) {
            { pg8::EpiResid E{xres, xresc, xres, xresc, modl + 5 * DM, 1.0f}; run_gemm(F, WSP(bf16_t, WS_HMOD), (const bf16_t*)(wl + LW_WOUT), TX, DM, DM, E); }
            if (l == 0) { pg8::Gemm g{WSP(bf16_t, WS_HMOD) + (size_t)TX * DM, (const bf16_t*)(wl + LW_WOUT), TC, DM, DM / 4, DM}; pg8::SplitKOrder S{F.G, F.bid, 4, DM / 4}; pg8::EpiPartial E{WSP(float, WS_PART), (DM / 4) * 2};
                pg8::gemm_phase<pg8::EpiPartial, pg8::SplitKOrder, PG8_ALIGN, PG8_SP2>(F.lds, g, S, E, F.tid); }
        }
        SEAM(pb + 10);
        if (IN(pb + 11)) norm_phase(F, xres, xresc, Mmix, modl, 6, 7, WSP(bf16_t, WS_HMOD), l == 0 ? WSP(float, WS_PART) : nullptr, modl + 8 * NMODC + 5 * DM, xresc, 1.0f);
        SEAM(pb + 11);
        if (IN(pb + 12)) { pg8::EpiSwiGLU E{WSP(bf16_t, WS_G), FF}; run_gemm(F, WSP(bf16_t, WS_HMOD), (const bf16_t*)(wl + LW_GU2), Mmix, 2 * FF, DM, E); }
        SEAM(pb + 12);
        if (IN(pb + 13)) { if (l == 0) run_down(F, WSP(bf16_t, WS_G), (const bf16_t*)(wl + LW_D2), xres, xres, modl + 8 * DM);
            else { pg8::EpiResid E{xres, xresc, F.out, xresc, modl + 8 * DM, 0.5f}; run_gemm(F, WSP(bf16_t, WS_G), (const bf16_t*)(wl + LW_D2), TX, DM, FF, E); } }
        if (l == 0) SEAM(pb + 13);
    }
#undef IN
#undef SEAM
#undef wl
#undef modl
#undef xres
#undef xresc
#undef srcx
#undef srcc
}

#ifndef MK_ONE_LAUNCH
#define MK_ONE_LAUNCH 1
#endif
extern "C" void kernel_launch(void* const* d_in, const int* in_sizes, int n_in, void* d_out, int out_size, void* d_ws, size_t ws_size, hipStream_t stream) {
    static int grid = 0;
    if (grid == 0) {
        if (n_in != N_IN || out_size != TX * DM || ws_size < WS_END) { fprintf(stderr, "kernel_launch: unexpected shapes (n_in %d, out %d, ws %zu < %zu)\n", n_in, out_size, ws_size, (size_t)WS_END); grid = -1; return; }
        int dev = 0, cus = 0, per_cu = 0;
        if (hipGetDevice(&dev) != hipSuccess || hipDeviceGetAttribute(&cus, hipDeviceAttributeMultiprocessorCount, dev) != hipSuccess) { grid = -1; return; }
        if (hipFuncSetAttribute((const void*)fwd_kernel, hipFuncAttributeMaxDynamicSharedMemorySize, LDS_BYTES) != hipSuccess) { fprintf(stderr, "kernel_launch: hipFuncSetAttribute failed\n"); grid = -1; return; }
        if (hipOccupancyMaxActiveBlocksPerMultiprocessor(&per_cu, (const void*)fwd_kernel, NTHR, LDS_BYTES) != hipSuccess || per_cu < 1) { fprintf(stderr, "kernel_launch: occupancy query reports %d blocks per CU\n", per_cu); }
        (void)hipGetLastError();
        grid = cus;
    }
    if (grid < 0) return;
    (void)hipMemsetAsync((char*)d_ws + WS_CTL, 0, CTL_BYTES, stream);
    (void)hipMemsetAsync((char*)d_ws + WS_MOD, 0, (size_t)2 * 9 * NMODC * 4, stream);
    Args a{};
    for (int i = 0; i < N_IN; ++i) a.in[i] = (const float*)d_in[i];
    a.out = (float*)d_out; a.ws = (unsigned char*)d_ws; a.pad = 15;
#if MK_ONE_LAUNCH
    a.ph_lo = 0; a.ph_hi = NPH;
    hipLaunchKernelGGL(fwd_kernel, dim3(grid), dim3(NTHR), LDS_BYTES, stream, a);
#ifdef PROBE_LO
    a.ph_lo = PROBE_LO; a.ph_hi = PROBE_HI; a.bar_sel = 1;
#ifdef PROBE_MASK
    a.pad = PROBE_MASK;
#endif
    hipLaunchKernelGGL(fwd_kernel, dim3(grid), dim3(NTHR), LDS_BYTES, stream, a);
#endif
#else
    for (int ph = 0; ph < NPH; ++ph) { a.ph_lo = ph; a.ph_hi = ph + 1; hipLaunchKernelGGL(fwd_kernel, dim3(grid), dim3(NTHR), LDS_BYTES, stream, a); }
#endif
}
```

```cpp
#include <hip/hip_runtime.h>
#include <cstdio>
#include <cstdint>
#include <cmath>

namespace pg8 {
#define PG8_LAS __attribute__((address_space(3)))
typedef unsigned short bf16_t;
typedef short bf16x8 __attribute__((ext_vector_type(8)));
typedef float f32x4 __attribute__((ext_vector_type(4)));
typedef unsigned u32x4 __attribute__((ext_vector_type(4)));
constexpr int BM = 256, BK = 64, HALF = 128, HTB = HALF * BK * 2, STAGE_BYTES = 8 * HTB, NXCD = 8, WGM = 4;

__host__ __device__ __forceinline__ int lds_byte(int r, int c) { const int st = (r >> 4) * 2 + (c >> 5), rr = r & 15, cc = c & 31, ob = rr * 64 + cc * 2; return st * 1024 + (ob ^ (((ob >> 9) & 1) << 5)); }
__host__ __device__ __forceinline__ void stage_rc(int b, int& R, int& C) { const int st = b / 1024, sb = b % 1024, swz = sb ^ (((sb >> 9) & 1) << 5); R = (st >> 1) * 16 + swz / 64; C = (st & 1) * 32 + (swz % 64) / 2; }
__host__ __device__ __forceinline__ int perm32(int rho) { const int n = rho >> 4, i = rho & 15; return 8 * (i >> 2) + 4 * n + (i & 3); }

struct Unit { int pm, pn, koff; };
struct Gemm { const bf16_t* A; const bf16_t* Bt; int M, N, K, ld; };

struct StaticOrder {
    int nM, nN, nwg, G, c, wgm;
    __host__ __device__ void init(int M, int N, int G_, int c_, int wgm_ = WGM) { nM = M / BM; nN = N / BM; nwg = nM * nN; G = G_; c = c_; wgm = wgm_; }
    __host__ __device__ bool next(int i, Unit& u) const {
        const long L = (long)i * G + c; if (L >= nwg) return false;
        int wgid = (int)L; { const int q = nwg / NXCD, r = nwg % NXCD, xcd = wgid % NXCD, off = wgid / NXCD; wgid = (xcd < r ? xcd * (q + 1) : r * (q + 1) + (xcd - r) * q) + off; }
        const int nig = wgm * nN, gid = wgid / nig, fm = gid * wgm, gsz = (nM - fm) < wgm ? (nM - fm) : wgm;
        u.pm = fm + ((wgid % nig) % gsz); u.pn = (wgid % nig) / gsz; u.koff = 0; return true;
    }
    __device__ __forceinline__ void a_ready(const Unit&) const {}
    __device__ __forceinline__ void done(const Unit&) const {}
};

struct SplitKOrder {
    int G, c, KS, kc;
    __device__ __forceinline__ bool next(int i, Unit& u) const { const int L = i * G + c; if (L >= 64 * KS) return false; const int ks = L % KS, t = L / KS; u.pn = t & 7; u.pm = t >> 3; u.koff = ks * kc * 2; return true; }
    __device__ __forceinline__ void a_ready(const Unit&) const {}
    __device__ __forceinline__ void done(const Unit&) const {}
};
__device__ __forceinline__ unsigned cvt_pk_bf16(float lo, float hi) { unsigned r; asm volatile("v_cvt_pk_bf16_f32 %0, %1, %2" : "=v"(r) : "v"(lo), "v"(hi)); return r; }

__device__ __forceinline__ float silu_f(float x) { return x * __builtin_amdgcn_rcpf(1.0f + __builtin_amdgcn_exp2f(-1.44269504089f * x)); }

struct EpiBf16 {
    static constexpr bool PERM = true, AFTER_DRAIN = false;
    bf16_t* O; int ldc;
    __device__ __forceinline__ void operator()(const f32x4 (&acc)[2][2][4][2], const Unit& u, int wr, int wc, int fr, int fq) const {
        const int row0 = u.pm * BM + wr * 64 + fr, col0 = u.pn * BM + wc * 32 + 8 * fq;
#pragma unroll
        for (int ai = 0; ai < 2; ++ai)
#pragma unroll
            for (int m = 0; m < 4; ++m) { bf16_t* rowp = O + (size_t)(row0 + ai * HALF + m * 16) * ldc + col0;
#pragma unroll
                for (int bj = 0; bj < 2; ++bj) { const f32x4 v0 = acc[ai][bj][m][0], v1 = acc[ai][bj][m][1];
                    u32x4 w; w.x = cvt_pk_bf16(v0[0], v0[1]); w.y = cvt_pk_bf16(v0[2], v0[3]); w.z = cvt_pk_bf16(v1[0], v1[1]); w.w = cvt_pk_bf16(v1[2], v1[3]);
                    *(u32x4*)(rowp + bj * HALF) = w; } }
    }
};
struct EpiSwiGLU {
    static constexpr bool PERM = true, AFTER_DRAIN = false;
    bf16_t* O; int ldc;
    __device__ __forceinline__ void operator()(const f32x4 (&acc)[2][2][4][2], const Unit& u, int wr, int wc, int fr, int fq) const {
        const int row0 = u.pm * BM + wr * 64 + fr, col0 = u.pn * HALF + wc * 32 + 8 * fq;
#pragma unroll
        for (int ai = 0; ai < 2; ++ai)
#pragma unroll
            for (int m = 0; m < 4; ++m) { bf16_t* rowp = O + (size_t)(row0 + ai * HALF + m * 16) * ldc + col0;
                const f32x4 g0 = acc[ai][0][m][0], g1 = acc[ai][0][m][1], u0 = acc[ai][1][m][0], u1 = acc[ai][1][m][1];
                float r[8];
#pragma unroll
                for (int j = 0; j < 4; ++j) { r[j] = silu_f(g0[j]) * u0[j]; r[4 + j] = silu_f(g1[j]) * u1[j]; }
                u32x4 w; w.x = cvt_pk_bf16(r[0], r[1]); w.y = cvt_pk_bf16(r[2], r[3]); w.z = cvt_pk_bf16(r[4], r[5]); w.w = cvt_pk_bf16(r[6], r[7]);
                *(u32x4*)rowp = w; }
    }
};
struct EpiPartial {
    static constexpr bool PERM = false, AFTER_DRAIN = false;
    float* part; int kbytes;
    __device__ __forceinline__ void operator()(const f32x4 (&acc)[2][2][4][2], const Unit& u, int wr, int wc, int fr, int fq) const {
        const int rl0 = wr * 64 + fr, col0 = u.pn * BM + wc * 32 + 4 * fq, ks = u.koff / kbytes;
        float* op = part + ((size_t)ks * 2048 + (size_t)u.pm * BM) * 2048;
#pragma unroll
        for (int ai = 0; ai < 2; ++ai)
#pragma unroll
            for (int m = 0; m < 4; ++m) { float* o = op + (size_t)(rl0 + ai * HALF + m * 16) * 2048 + col0;
#pragma unroll
                for (int bj = 0; bj < 2; ++bj)
#pragma unroll
                    for (int n = 0; n < 2; ++n) *(f32x4*)(o + bj * HALF + n * 16) = acc[ai][bj][m][n]; }
    }
};
struct EpiResid {
    static constexpr bool PERM = false, AFTER_DRAIN = false;
    const float* resx; const float* resc; float* outx; float* outc; const float* gate; float coef;
    __device__ __forceinline__ void operator()(const f32x4 (&acc)[2][2][4][2], const Unit& u, int wr, int wc, int fr, int fq) const {
        const int rl0 = wr * 64 + fr, col0 = u.pn * BM + wc * 32 + 4 * fq;
        const bool isx = u.pm < 64;
        const float* rp = isx ? resx + (size_t)u.pm * BM * 2048 : resc + (size_t)(u.pm - 64) * BM * 2048;
        float* op = isx ? outx + (size_t)u.pm * BM * 2048 : outc + (size_t)(u.pm - 64) * BM * 2048;
        const float* gp = gate + (size_t)(isx ? (u.pm >> 3) : 8) * 18432 + col0;
#pragma unroll
        for (int bj = 0; bj < 2; ++bj)
#pragma unroll
            for (int n = 0; n < 2; ++n) { const f32x4 gv = *(const f32x4*)(gp + bj * HALF + n * 16) * coef;
#pragma unroll
                for (int ai = 0; ai < 2; ++ai)
#pragma unroll
                    for (int m = 0; m < 4; ++m) { const size_t off = (size_t)(rl0 + ai * HALF + m * 16) * 2048 + col0 + bj * HALF + n * 16;
                        const f32x4 bs = *(const f32x4*)(rp + off);
                        *(f32x4*)(op + off) = bs + gv * acc[ai][bj][m][n]; }
                asm volatile("" ::: "memory"); }
    }
};

template <class Epi, class Sched, bool ALIGN_EPI = false, bool SP2 = false>
__device__ __forceinline__ void gemm_phase(PG8_LAS unsigned char* lds, const Gemm g, const Sched& S, const Epi& E, int tid) {
    asm volatile("" : "+v"(tid));
    const int  wid = __builtin_amdgcn_readfirstlane(tid >> 6), lane = tid & 63, wr = wid >> 2, wc = wid & 3, fr = lane & 15, fq = lane >> 4;
    const int K = g.ld, nt = g.K / BK;
    unsigned voffA[2], voffB[2];
#pragma unroll
    for (int i = 0; i < 2; ++i) { int R, C; stage_rc(tid * 16 + i * 8192, R, C); const int Rb = Epi::PERM ? ((R & ~31) + perm32(R & 31)) : R;
        voffA[i] = (unsigned)(R * K + C) * 2u; voffB[i] = (unsigned)(Rb * K + C) * 2u; }
    const size_t kstep = (size_t)(BK * 2);
    const size_t hstep = (size_t)HALF * K * 2;
    const size_t tstep = 2 * hstep;
    const unsigned ldsw = (unsigned)wid * 1024u;
    const int aoff = lds_byte(wr * 64 + fr, fq * 8), boff = lds_byte(wc * 32 + fr, fq * 8);
#define PG8_SA(b, h) (((b) * 2 + (h)) * HTB)
#define PG8_SB(b, h) ((4 + (b) * 2 + (h)) * HTB)
#define PG8_STAGE(bufoff, gbase, voff) do { _Pragma("unroll") for (int _i = 0; _i < 2; ++_i) \
        __builtin_amdgcn_global_load_lds((const unsigned*)((const char*)(gbase) + (voff)[_i]), (PG8_LAS unsigned*)(lds + (bufoff) + ldsw + _i * 8192), 16, 0, 0); } while (0)
#define PG8_LDA(dst, b, h) do { _Pragma("unroll") for (int m = 0; m < 4; ++m) _Pragma("unroll") for (int k = 0; k < 2; ++k) dst[m][k] = *(const PG8_LAS bf16x8*)(lds + PG8_SA(b, h) + aoff + m * 2048 + k * 1024); } while (0)
#define PG8_LDB(dst, b, h) do { _Pragma("unroll") for (int n = 0; n < 2; ++n) _Pragma("unroll") for (int k = 0; k < 2; ++k) dst[n][k] = *(const PG8_LAS bf16x8*)(lds + PG8_SB(b, h) + boff + n * 2048 + k * 1024); } while (0)
#define PG8_MMA(ai, bj, At, Bt) do { __builtin_amdgcn_s_setprio(1); _Pragma("unroll") for (int m = 0; m < 4; ++m) _Pragma("unroll") for (int n = 0; n < 2; ++n) _Pragma("unroll") for (int k = 0; k < 2; ++k) \
        acc[ai][bj][m][n] = __builtin_amdgcn_mfma_f32_16x16x32_bf16(Bt[n][k], At[m][k], acc[ai][bj][m][n], 0, 0, 0); __builtin_amdgcn_s_setprio(0); } while (0)
#define PG8_WAIT_V(n) asm volatile("s_waitcnt vmcnt(" #n ")" ::: "memory")
#define PG8_WAIT_L(n) asm volatile("s_waitcnt lgkmcnt(" #n ")" ::: "memory")
#define PG8_BAR __builtin_amdgcn_s_barrier()
#define PG8_SCHED __builtin_amdgcn_sched_barrier(0)
    Unit cur, nxt; int ui = 0;
    if (!S.next(0, cur)) return;
    f32x4 acc[2][2][4][2];
#pragma unroll
    for (int a = 0; a < 2; ++a)
#pragma unroll
        for (int b = 0; b < 2; ++b)
#pragma unroll
            for (int m = 0; m < 4; ++m)
#pragma unroll
                for (int n = 0; n < 2; ++n) acc[a][b][m][n] = (f32x4){0.f, 0.f, 0.f, 0.f};
    bf16x8 At[4][2], B0[2][2], B1[2][2];
    const char* cA = (const char*)g.A + (size_t)cur.pm * tstep + cur.koff; const char* cB = (const char*)g.Bt + (size_t)cur.pn * tstep + cur.koff;
    S.a_ready(cur);
    if constexpr (SP2) {
        PG8_STAGE(PG8_SB(0, 0), cB, voffB); PG8_STAGE(PG8_SB(0, 1), cB + hstep, voffB); PG8_STAGE(PG8_SA(0, 0), cA, voffA); PG8_STAGE(PG8_SA(0, 1), cA + hstep, voffA);
        if (wr == 1) PG8_BAR;
        PG8_WAIT_V(2); PG8_BAR;
        PG8_STAGE(PG8_SB(1, 0), cB + kstep, voffB); PG8_STAGE(PG8_SA(1, 0), cA + kstep, voffA); PG8_STAGE(PG8_SB(1, 1), cB + hstep + kstep, voffB);
        PG8_WAIT_V(6); PG8_BAR;
    } else {
        PG8_STAGE(PG8_SB(0, 0), cB, voffB); PG8_STAGE(PG8_SA(0, 0), cA, voffA); PG8_STAGE(PG8_SB(0, 1), cB + hstep, voffB); PG8_STAGE(PG8_SA(0, 1), cA + hstep, voffA);
        if (wr == 1) PG8_BAR;
        PG8_WAIT_V(4); PG8_BAR;
        PG8_STAGE(PG8_SB(1, 0), cB + kstep, voffB); PG8_STAGE(PG8_SA(1, 0), cA + kstep, voffA); PG8_STAGE(PG8_SB(1, 1), cB + hstep + kstep, voffB);
        PG8_WAIT_V(6); PG8_BAR;
    }
    for (;;) {
        const bool has_next = S.next(ui + 1, nxt);
        const char* nA = has_next ? (const char*)g.A + (size_t)nxt.pm * tstep + nxt.koff : cA; const char* nB = has_next ? (const char*)g.Bt + (size_t)nxt.pn * tstep + nxt.koff : cB;
        for (int t = 0; t < nt; t += 2) {
            const bool last = (t == nt - 2);
            const char* a1 = cA + (size_t)(t + 1) * kstep;
            const char* a2 = last ? nA : cA + (size_t)(t + 2) * kstep; const char* b2 = last ? nB : cB + (size_t)(t + 2) * kstep;
            const char* a3 = a2 + kstep; const char* b3 = b2 + kstep;
            if (last && has_next) S.a_ready(nxt);
            if constexpr (SP2) {
            PG8_LDB(B0, 0, 0); PG8_LDB(B1, 0, 1); PG8_SCHED; PG8_LDA(At, 0, 0); PG8_STAGE(PG8_SA(1, 1), a1 + hstep, voffA);
            PG8_WAIT_V(8); PG8_WAIT_L(0); PG8_BAR; PG8_MMA(0, 0, At, B0); PG8_MMA(0, 1, At, B1); PG8_BAR; PG8_SCHED;
            PG8_LDA(At, 0, 1); PG8_STAGE(PG8_SB(0, 0), b2, voffB); PG8_STAGE(PG8_SB(0, 1), b2 + hstep, voffB); PG8_STAGE(PG8_SA(0, 0), a2, voffA);
            PG8_WAIT_V(8); PG8_WAIT_L(0); PG8_BAR; PG8_MMA(1, 0, At, B0); PG8_MMA(1, 1, At, B1); PG8_BAR; PG8_SCHED;
            PG8_LDB(B0, 1, 0); PG8_LDB(B1, 1, 1); PG8_SCHED; PG8_LDA(At, 1, 0); PG8_STAGE(PG8_SA(0, 1), a2 + hstep, voffA);
            PG8_WAIT_V(8); PG8_WAIT_L(0); PG8_BAR; PG8_MMA(0, 0, At, B0); PG8_MMA(0, 1, At, B1); PG8_BAR; PG8_SCHED;
            PG8_LDA(At, 1, 1); PG8_STAGE(PG8_SB(1, 0), b3, voffB); PG8_STAGE(PG8_SB(1, 1), b3 + hstep, voffB); PG8_STAGE(PG8_SA(1, 0), a3, voffA);
            PG8_WAIT_V(8); PG8_WAIT_L(0); PG8_BAR; PG8_MMA(1, 0, At, B0); PG8_MMA(1, 1, At, B1); PG8_BAR; PG8_SCHED;
            } else {
            PG8_LDB(B0, 0, 0); PG8_SCHED; PG8_LDA(At, 0, 0); PG8_STAGE(PG8_SA(1, 1), a1 + hstep, voffA);
            PG8_WAIT_L(8); PG8_BAR; PG8_WAIT_L(0); PG8_MMA(0, 0, At, B0); PG8_BAR; PG8_SCHED;
            PG8_LDB(B1, 0, 1); PG8_STAGE(PG8_SB(0, 0), b2, voffB);
            PG8_BAR; PG8_WAIT_L(0); PG8_MMA(0, 1, At, B1); PG8_BAR;
            PG8_LDA(At, 0, 1); PG8_STAGE(PG8_SA(0, 0), a2, voffA);
            PG8_BAR; PG8_WAIT_L(0); PG8_MMA(1, 0, At, B0); PG8_BAR; PG8_SCHED;
            PG8_STAGE(PG8_SB(0, 1), b2 + hstep, voffB);
            PG8_WAIT_V(6); PG8_BAR; PG8_MMA(1, 1, At, B1); PG8_BAR;
            PG8_LDB(B0, 1, 0); PG8_SCHED; PG8_LDA(At, 1, 0); PG8_STAGE(PG8_SA(0, 1), a2 + hstep, voffA);
            PG8_WAIT_L(8); PG8_BAR; PG8_WAIT_L(0); PG8_MMA(0, 0, At, B0); PG8_BAR; PG8_SCHED;
            PG8_LDB(B1, 1, 1); PG8_STAGE(PG8_SB(1, 0), b3, voffB);
            PG8_BAR; PG8_WAIT_L(0); PG8_MMA(0, 1, At, B1); PG8_BAR;
            PG8_LDA(At, 1, 1); PG8_STAGE(PG8_SA(1, 0), a3, voffA);
            PG8_BAR; PG8_WAIT_L(0); PG8_MMA(1, 0, At, B0); PG8_BAR; PG8_SCHED;
            PG8_STAGE(PG8_SB(1, 1), b3 + hstep, voffB);
            PG8_WAIT_V(6); PG8_BAR; PG8_MMA(1, 1, At, B1); PG8_BAR;
            }
        }
        if constexpr (ALIGN_EPI) { if (wr == 0) PG8_BAR; }
        if constexpr (!Epi::AFTER_DRAIN) { E(acc, cur, wr, wc, fr, fq); S.done(cur); }
        if (!has_next) break;
#pragma unroll
        for (int a = 0; a < 2; ++a)
#pragma unroll
            for (int b = 0; b < 2; ++b)
#pragma unroll
                for (int m = 0; m < 4; ++m)
#pragma unroll
                    for (int n = 0; n < 2; ++n) acc[a][b][m][n] = (f32x4){0.f, 0.f, 0.f, 0.f};
        cur = nxt; cA = nA; cB = nB; ++ui;
        if constexpr (ALIGN_EPI) { if (wr == 1) PG8_BAR; }
    }
    PG8_WAIT_V(0);
    if constexpr (!ALIGN_EPI) { if (wr == 0) PG8_BAR; }
    PG8_BAR;
    if constexpr (Epi::AFTER_DRAIN) { E.fused(acc, cur, wr, wc, fr, fq, lds, wid, lane); S.done(cur); }
#undef PG8_SA
#undef PG8_SB
#undef PG8_STAGE
#undef PG8_LDA
#undef PG8_LDB
#undef PG8_MMA
#undef PG8_WAIT_V
#undef PG8_WAIT_L
#undef PG8_BAR
#undef PG8_SCHED
}
}

constexpr int NWAVES = 8, NTHR = 512;
constexpr int DM = 2048, NB = 8, SEQ = 2048, CTXL = 256, FF = 5632;
constexpr int TX = NB * SEQ, TC = NB * CTXL, TT = TX + TC;
constexpr int NMODC = 9 * DM;
constexpr float EPS = 1e-6f;
constexpr int ZC_KV = 0, ZC_RK = 256, ZC_RV = 512, ZC_KR = 1024, ZC_Q = 1280, ZC_RQ = 1792, ZC_RG = 2048, ZLD = 2560;
constexpr int NPH_L = 14, NPH = 2 + 2 * NPH_L;

enum { IN_X = 0, IN_C, IN_CTX, IN_CCTX, IN_ADAW, IN_ADAB, IN_F1G, IN_F1U, IN_F1D, IN_WIN, IN_QNORM, IN_WUQ, IN_KVNORM, IN_WUKV, IN_QNNOPE, IN_QNROPE, IN_KNNOPE, IN_KNROPE, IN_OUTNORM,
       IN_HCW, IN_HCB, IN_HW1, IN_HB1, IN_HW2, IN_HB2, IN_HW3, IN_HSKIP, IN_HONORM, IN_RDECAY, IN_RGNW, IN_RGNB, IN_WOUT, IN_F2G, IN_F2U, IN_F2D, N_IN };

constexpr size_t MiB = 1u << 20;
constexpr size_t SZ_WGU = (size_t)2 * FF * DM * 2, SZ_WD = (size_t)DM * FF * 2, SZ_WINM = (size_t)ZLD * DM * 2, SZ_WINH = (size_t)1536 * DM * 2,
                 SZ_WUQ = (size_t)1536 * 512 * 2, SZ_WUKV = (size_t)2048 * 256 * 2, SZ_WOUT = (size_t)DM * DM * 2;
constexpr size_t LW_GU1 = 0, LW_D1 = LW_GU1 + SZ_WGU, LW_GU2 = LW_D1 + SZ_WD, LW_D2 = LW_GU2 + SZ_WGU, LW_WINM = LW_D2 + SZ_WD, LW_WINH = LW_WINM + SZ_WINM,
                 LW_WUQ = LW_WINH + SZ_WINH, LW_WUKV = LW_WUQ + SZ_WUQ, LW_WOUT = LW_WUKV + SZ_WUKV, LW = LW_WOUT + SZ_WOUT;
constexpr size_t WS_CTL = 0, CTL_BYTES = 65536;
constexpr size_t WS_MOD = CTL_BYTES;
constexpr size_t WS_W = WS_MOD + (size_t)2 * 9 * NMODC * 4;
constexpr size_t WS_MODP = WS_W + 2 * LW;
constexpr size_t WS_H2 = WS_MODP;
constexpr size_t WS_H2C = WS_H2 + (size_t)2 * 2048 * 64 * 4;
constexpr size_t WS_TAPS = WS_H2C + (size_t)256 * 64 * 4;
constexpr size_t WS_TAPSC = WS_TAPS + (size_t)2 * 2 * 512 * 4096 * 4;
constexpr size_t WS_XRES = WS_TAPSC + (size_t)2 * 512 * 512 * 4;
constexpr size_t WS_HMOD = WS_XRES + (size_t)TT * DM * 4;
constexpr size_t WS_R = WS_HMOD + (size_t)TT * DM * 2;
constexpr size_t WS_G = WS_R;
constexpr size_t WS_Z = WS_R;
constexpr size_t WS_ZT = WS_Z + (size_t)TT * ZLD * 2;
constexpr size_t WS_KVN = WS_ZT + (size_t)1536 * TT * 2;
constexpr size_t WS_QN = WS_KVN + (size_t)TT * 256 * 2;
constexpr size_t WS_KROPE = WS_QN + (size_t)TT * 512 * 2;
constexpr size_t WS_KV = WS_KROPE + (size_t)TT * 64 * 2;
constexpr size_t WS_Q = WS_KV + (size_t)TT * 2048 * 2;
constexpr size_t WS_BQ = WS_Q + (size_t)TT * 1536 * 2;
constexpr size_t WS_AO = WS_BQ + (size_t)TT * 8 * 4;
constexpr size_t WS_HY = WS_AO + (size_t)TT * 1024 * 2;
constexpr size_t WS_RO = WS_HY + (size_t)512 * TT * 4;
constexpr size_t WS_PART = WS_RO + (size_t)2 * TT * 512 * 4;
constexpr size_t WS_END = WS_PART + (size_t)4 * TC * DM * 4;
static_assert(WS_G + (size_t)TT * FF * 2 <= WS_END, "G fits in the region");
static_assert(WS_END <= (size_t)1207959552, "workspace map must fit 4x the largest input");
static_assert(WS_W % 256 == 0 && LW % 256 == 0 && WS_MODP % 256 == 0 && WS_XRES % 256 == 0 && WS_R % 256 == 0 && WS_ZT % 256 == 0 && WS_KV % 256 == 0 && WS_Q % 256 == 0 && WS_HY % 256 == 0, "alignment");

constexpr int CW_BAR = 4096;

constexpr int RING_BYTES = 131072, LDSCTL_OFF = RING_BYTES, MISC_OFF = LDSCTL_OFF + 320, LDS_BYTES = 147456;

#define GAS __attribute__((address_space(1)))
#define LAS __attribute__((address_space(3)))
typedef unsigned short bf16_t;
typedef unsigned v4u __attribute__((ext_vector_type(4)));
typedef unsigned v2u __attribute__((ext_vector_type(2)));
typedef float f32x4 __attribute__((ext_vector_type(4)));
#define LDS_WAIT() asm volatile("s_waitcnt lgkmcnt(0)" ::: "memory")
#define VM_WAIT() asm volatile("s_waitcnt vmcnt(0)" ::: "memory")
__device__ __forceinline__ unsigned f2bf(float f) { unsigned u = __builtin_bit_cast(unsigned, f); return (u + 0x7fffu + ((u >> 16) & 1u)) >> 16; }
__device__ __forceinline__ unsigned pk2(float lo, float hi) { return f2bf(lo) | (f2bf(hi) << 16); }
__device__ __forceinline__ float bflo(unsigned w) { return __builtin_bit_cast(float, w << 16); }
__device__ __forceinline__ float bfhi(unsigned w) { return __builtin_bit_cast(float, w & 0xffff0000u); }
__device__ __forceinline__ float bf1(bf16_t b) { return __builtin_bit_cast(float, (unsigned)b << 16); }
template <int M> __device__ __forceinline__ float sx(float v) { static_assert(M >= 1 && M <= 16, "xor mask inside a 32-lane half"); return __builtin_bit_cast(float, __builtin_amdgcn_ds_swizzle(__builtin_bit_cast(int, v), (M << 10) | 0x1f)); }
__device__ __forceinline__ float half_sum(float v) { const int u = __builtin_bit_cast(int, v); return __builtin_bit_cast(float, __builtin_amdgcn_readlane(u, 0)) + __builtin_bit_cast(float, __builtin_amdgcn_readlane(u, 32)); }
__device__ __forceinline__ float half_max(float v) { const int u = __builtin_bit_cast(int, v); return fmaxf(__builtin_bit_cast(float, __builtin_amdgcn_readlane(u, 0)), __builtin_bit_cast(float, __builtin_amdgcn_readlane(u, 32))); }
__device__ __forceinline__ float wave_sum(float v) { v += sx<1>(v); v += sx<2>(v); v += sx<4>(v); v += sx<8>(v); v += sx<16>(v); return half_sum(v); }
__device__ __forceinline__ float wave_max(float v) { v = fmaxf(v, sx<1>(v)); v = fmaxf(v, sx<2>(v)); v = fmaxf(v, sx<4>(v)); v = fmaxf(v, sx<8>(v)); v = fmaxf(v, sx<16>(v)); return half_max(v); }
__device__ __forceinline__ float dot8(v4u a, v4u b, float s) {
    s = fmaf(bflo(a.x), bflo(b.x), s); s = fmaf(bfhi(a.x), bfhi(b.x), s); s = fmaf(bflo(a.y), bflo(b.y), s); s = fmaf(bfhi(a.y), bfhi(b.y), s);
    s = fmaf(bflo(a.z), bflo(b.z), s); s = fmaf(bfhi(a.z), bfhi(b.z), s); s = fmaf(bflo(a.w), bflo(b.w), s); s = fmaf(bfhi(a.w), bfhi(b.w), s); return s;
}

#define XB_TMO      128
#define XB_XCNT(j)  (256  + 64 * (j))
#define XB_XSUB(j)  (1280 + 64 * (j))
#define XB_XGEN(j)  (2304 + 64 * (j))
#define XB_TOP      3328
#define XB_TOPGEN   3392
#define XCD_BAR_WORDS 3456
#define XB_SPIN_CAP (1u << 22)
__device__ __forceinline__ unsigned xb_ld(unsigned* p)              { return __hip_atomic_load(p, __ATOMIC_RELAXED, __HIP_MEMORY_SCOPE_AGENT); }
__device__ __forceinline__ unsigned xb_add(unsigned* p, unsigned v) { return __hip_atomic_fetch_add(p, v, __ATOMIC_RELAXED, __HIP_MEMORY_SCOPE_AGENT); }
__device__ __forceinline__ unsigned xb_xcc_id() { return (unsigned)__builtin_amdgcn_s_getreg((3 << 11) | 20) & 0xFu; }
#define XB_SPIN(cond, bar) do { unsigned _sp = 0; while (cond) { __builtin_amdgcn_s_sleep(1); \
    if ((++_sp & 255u) == 0u) { if (xb_ld(&(bar)[XB_TMO])) break; if (_sp > XB_SPIN_CAP) { atomicAdd(&(bar)[XB_TMO], 1u); break; } } } } while (0)
struct XcdBarrier { unsigned* bar; unsigned x; volatile LAS unsigned* st; };
__device__ __forceinline__ XcdBarrier xcd_barrier_post(unsigned* bar, volatile LAS unsigned* st, int tid) {
    XcdBarrier b; b.bar = bar; b.x = xb_xcc_id(); b.st = st;
    if (tid == 0) (void)xb_add(&bar[XB_XCNT(b.x)], 1u);
    return b;
}
__device__ __forceinline__ void xcd_barrier_complete(unsigned* bar, unsigned x, unsigned& nloc, unsigned& nx) {
    const unsigned G = gridDim.x * gridDim.y * gridDim.z;
    unsigned sum, cnt, mine, sp = 0u;
    for (;;) {
        sum = 0u; cnt = 0u; mine = 0u;
#pragma unroll
        for (unsigned j = 0; j < 16; ++j) { const unsigned c = xb_ld(&bar[XB_XCNT(j)]); sum += c; cnt += (c > 0u) ? 1u : 0u; mine = (j == x) ? c : mine; }
        if (sum == G) break;
        __builtin_amdgcn_s_sleep(1);
        if ((++sp & 255u) == 0u) { if (xb_ld(&bar[XB_TMO])) break; if (sp > XB_SPIN_CAP) { atomicAdd(&bar[XB_TMO], 1u); break; } }
    }
    nloc = mine > 0u ? mine : 1u; nx = cnt > 0u ? cnt : 1u;
}
__device__ __forceinline__ void xcd_barrier(const XcdBarrier& b, int tid) {
    asm volatile("s_waitcnt vmcnt(0)" ::: "memory");
    __syncthreads();
    if (tid == 0) {
        unsigned* bar = b.bar;
        __builtin_amdgcn_s_waitcnt(0);
        unsigned nloc = b.st[0], nx = b.st[1];
        if (nloc == 0u) { xcd_barrier_complete(bar, b.x, nloc, nx); b.st[0] = nloc; b.st[1] = nx; }
        const unsigned old = xb_add(&bar[XB_XSUB(b.x)], 1u);
        const unsigned gen = old / nloc;
        if (old + 1u == (gen + 1u) * nloc) {
            __builtin_amdgcn_fence(__ATOMIC_RELEASE, "agent");
            asm volatile("s_waitcnt vmcnt(0)" ::: "memory");
            const unsigned og = xb_add(&bar[XB_TOP], 1u);
            const unsigned tg = og / nx;
            if (og + 1u == (tg + 1u) * nx) xb_add(&bar[XB_TOPGEN], 1u);
            else XB_SPIN(xb_ld(&bar[XB_TOPGEN]) == tg, bar);
            __builtin_amdgcn_fence(__ATOMIC_ACQUIRE, "agent");
            xb_add(&bar[XB_XGEN(b.x)], 1u);
            asm volatile("s_waitcnt vmcnt(0)" ::: "memory");
        } else {
            XB_SPIN(xb_ld(&bar[XB_XGEN(b.x)]) == gen, bar);
            __builtin_amdgcn_fence(__ATOMIC_ACQUIRE, "agent");
            asm volatile("s_waitcnt vmcnt(0)" ::: "memory");
        }
    }
    __syncthreads();
}

struct Args { const float* in[N_IN]; float* out; unsigned char* ws; int ph_lo, ph_hi, bar_sel, pad; };
struct Frame {
    LAS unsigned char* lds;
    int tid, lane, wave, G, gw, NGW, bid, wave0;
    const float* const* in; unsigned char* ws; float* out;
};
#define WSP(T, off) ((T*)(F.ws + (off)))

struct WJob { const float* w; bf16_t* o; int ldw, K; bool zero; };
__device__ __forceinline__ WJob wjob_make(const float* W, int ldw, int K, int srccol0, bf16_t* WT, int dstrow0, int kb, bool zero = false) {
    WJob j; j.w = W + (size_t)(64 * kb) * ldw + srccol0; j.o = WT + (size_t)dstrow0 * K + 64 * kb; j.ldw = ldw; j.K = K; j.zero = zero; return j; }
__device__ __forceinline__ void wj_load(const WJob& j, float (&t)[32], int lane) {
    const float* wp = j.w + (size_t)(lane >> 5) * j.ldw + (lane & 31);
#pragma unroll
    for (int i = 0; i < 32; ++i) t[i] = wp[(size_t)(2 * i) * j.ldw];
}
__device__ __forceinline__ void wj_store(const WJob& j, const float (&t)[32], LAS float* scr, int lane) {
#pragma unroll
    for (int i = 0; i < 32; ++i) scr[(2 * i + (lane >> 5)) * 33 + (lane & 31)] = j.zero ? 0.f : t[i];
    LDS_WAIT(); asm volatile("" ::: "memory");
    const int c = lane & 7;
#pragma unroll
    for (int q = 0; q < 4; ++q) { const int n = (lane >> 3) + 8 * q; const LAS float* s = scr + (8 * c) * 33 + n;
        v4u o; o.x = pk2(s[0 * 33], s[1 * 33]); o.y = pk2(s[2 * 33], s[3 * 33]); o.z = pk2(s[4 * 33], s[5 * 33]); o.w = pk2(s[6 * 33], s[7 * 33]);
        *(v4u*)(j.o + (size_t)n * j.K + 8 * c) = o; }
    LDS_WAIT(); asm volatile("" ::: "memory");
}
constexpr int J_GU_RB = 2 * FF / 32, J_GU_KB = DM / 64, J_D_RB = DM / 32, J_D_KB = FF / 64, J_WM_RB = ZLD / 32, J_WH_RB = 1536 / 32, J_IN_KB = DM / 64,
              J_UQ_RB = 1536 / 32, J_UQ_KB = 512 / 64, J_UKV_RB = 2048 / 32, J_UKV_KB = 256 / 64, J_O_RB = DM / 32, J_O_KB = DM / 64;
constexpr int JI_GU = J_GU_RB * J_GU_KB, JI_D = J_D_RB * J_D_KB, JI_WM = J_WM_RB * J_IN_KB, JI_WH = J_WH_RB * J_IN_KB, JI_UQ = J_UQ_RB * J_UQ_KB, JI_UKV = J_UKV_RB * J_UKV_KB, JI_O = J_O_RB * J_O_KB;
constexpr int JI_LAYER = 2 * JI_GU + 2 * JI_D + JI_WM + JI_WH + JI_UQ + JI_UKV + JI_O;
__device__ __forceinline__ WJob wjob_gu(const float* Wg, const float* Wu, bf16_t* dst, int r) {
    const int rb = r / J_GU_KB, kb = r % J_GU_KB, tile = rb >> 3, within = rb & 7;
    return wjob_make(within < 4 ? Wg : Wu, FF, DM, tile * 128 + (within & 3) * 32, dst, rb * 32, kb);
}
__device__ __forceinline__ WJob wjob(const Frame& F, int it) {
    const int l = it / JI_LAYER; int r = it % JI_LAYER;
    unsigned char* wl = F.ws + WS_W + (size_t)l * LW;
    if (r < JI_GU) return wjob_gu(F.in[IN_F1G] + (size_t)l * DM * FF, F.in[IN_F1U] + (size_t)l * DM * FF, (bf16_t*)(wl + LW_GU1), r);
    r -= JI_GU;
    if (r < JI_D) return wjob_make(F.in[IN_F1D] + (size_t)l * FF * DM, DM, FF, (r / J_D_KB) * 32, (bf16_t*)(wl + LW_D1), (r / J_D_KB) * 32, r % J_D_KB);
    r -= JI_D;
    if (r < JI_GU) return wjob_gu(F.in[IN_F2G] + (size_t)l * DM * FF, F.in[IN_F2U] + (size_t)l * DM * FF, (bf16_t*)(wl + LW_GU2), r);
    r -= JI_GU;
    if (r < JI_D) return wjob_make(F.in[IN_F2D] + (size_t)l * FF * DM, DM, FF, (r / J_D_KB) * 32, (bf16_t*)(wl + LW_D2), (r / J_D_KB) * 32, r % J_D_KB);
    r -= JI_D;
    if (r < JI_WM) { const int rb = r / J_IN_KB, kb = r % J_IN_KB, d0 = rb * 32; int src;
        if (d0 < 256) src = d0; else if (d0 < 512) src = 320 + (d0 - 256); else if (d0 < 1024) src = 576 + (d0 - 512); else if (d0 < 1088) src = 256 + (d0 - 1024);
        else if (d0 < 1280) src = -1; else if (d0 < 1792) src = 1088 + (d0 - 1280); else if (d0 < 2048) src = 1600 + (d0 - 1792); else src = 1856 + (d0 - 2048);
        return wjob_make(F.in[IN_WIN] + (size_t)l * DM * 3904, 3904, DM, src < 0 ? 0 : src, (bf16_t*)(wl + LW_WINM), d0, kb, src < 0); }
    r -= JI_WM;
    if (r < JI_WH) { const int rb = r / J_IN_KB, kb = r % J_IN_KB; return wjob_make(F.in[IN_WIN] + (size_t)l * DM * 3904, 3904, DM, 2368 + rb * 32, (bf16_t*)(wl + LW_WINH), rb * 32, kb); }
    r -= JI_WH;
    if (r < JI_UQ) { const int rb = r / J_UQ_KB, kb = r % J_UQ_KB; return wjob_make(F.in[IN_WUQ] + (size_t)l * 512 * 1536, 1536, 512, rb * 32, (bf16_t*)(wl + LW_WUQ), rb * 32, kb); }
    r -= JI_UQ;
    if (r < JI_UKV) { const int rb = r / J_UKV_KB, kb = r % J_UKV_KB; return wjob_make(F.in[IN_WUKV] + (size_t)l * 256 * 2048, 2048, 256, rb * 32, (bf16_t*)(wl + LW_WUKV), rb * 32, kb); }
    r -= JI_UKV;
    { const int rb = r / J_O_KB, kb = r % J_O_KB; return wjob_make(F.in[IN_WOUT] + (size_t)l * DM * DM, DM, DM, rb * 32, (bf16_t*)(wl + LW_WOUT), rb * 32, kb); }
}
__device__ __forceinline__ void p0_weights(const Frame& F) {
    LAS float* scr = (LAS float*)(F.lds + F.wave * 16384);
    constexpr int NIT = 2 * JI_LAYER; const int NPAIR = (NIT + 2 * F.NGW - 1) / (2 * F.NGW);
    int it = F.gw;
    WJob jA = wjob(F, it), jB; float tA[32], tB[32];
    wj_load(jA, tA, F.lane);
    for (int p = 0; p < NPAIR; ++p) {
        int nx = it + F.NGW; nx = nx < NIT ? nx : it;
        jB = wjob(F, nx); wj_load(jB, tB, F.lane);
        wj_store(jA, tA, scr, F.lane);
        it = nx; nx = it + F.NGW; nx = nx < NIT ? nx : it;
        jA = wjob(F, nx); wj_load(jA, tA, F.lane);
        wj_store(jB, tB, scr, F.lane);
        it = nx;
    }
}
__device__ __forceinline__ void p0_modpart(const Frame& F) {
    LAS float* sl = (LAS float*)F.lds;
    for (int it = F.bid; it < 2 * 9 * 8; it += F.G) {
        const int l = it / 72, rem = it % 72, jb = rem / 8, kc = rem % 8;
        __syncthreads();
        for (int idx = F.tid; idx < 9 * 256; idx += NTHR) { const int r = idx >> 8, k = idx & 255;
            const float cv = r < 8 ? F.in[IN_C][r * DM + kc * 256 + k] : F.in[IN_CCTX][kc * 256 + k];
            sl[idx] = cv / (1.0f + expf(-cv)); }
        __syncthreads();
        const int j = jb * 2048 + F.tid * 4;
        const f32x4* wp = (const f32x4*)(F.in[IN_ADAW] + ((size_t)l * DM + kc * 256) * NMODC + j);
        f32x4 acc[9];
#pragma unroll
        for (int r = 0; r < 9; ++r) acc[r] = (f32x4){0.f, 0.f, 0.f, 0.f};
        for (int k = 0; k < 256; k += 8) {
            f32x4 a[8];
#pragma unroll
            for (int q = 0; q < 8; ++q) a[q] = wp[(size_t)(k + q) * (NMODC / 4)];
#pragma unroll
            for (int q = 0; q < 8; ++q)
#pragma unroll
                for (int r = 0; r < 9; ++r) acc[r] = acc[r] + a[q] * sl[r * 256 + k + q];
        }
        float* mp = WSP(float, WS_MOD) + ((size_t)l * 9) * NMODC + j;
        f32x4 bias = (f32x4){0.f, 0.f, 0.f, 0.f}; if (kc == 0) bias = *(const f32x4*)(F.in[IN_ADAB] + l * NMODC + j);
#pragma unroll
        for (int r = 0; r < 9; ++r) { const f32x4 v = acc[r] + bias; float* o = mp + (size_t)r * NMODC;
            unsafeAtomicAdd(o + 0, v[0]); unsafeAtomicAdd(o + 1, v[1]); unsafeAtomicAdd(o + 2, v[2]); unsafeAtomicAdd(o + 3, v[3]); }
    }
    __syncthreads();
}
__device__ __forceinline__ void p0_hyh2(const Frame& F) {
    for (int it = F.gw; it < 2 * 2048 + 256; it += F.NGW) {
        const int l = it < 4096 ? it >> 11 : 0, type = it < 4096 ? 0 : 1, i = it < 4096 ? (it & 2047) : it - 4096, n = type ? 256 : 2048;
        const float t = (float)i / (float)(n - 1), w = (6.2831853071795864f * (float)i) / (float)n;
        float feat = 0.f;
        if (F.lane == 0) feat = t;
        else if (F.lane <= 32) { const int j = (F.lane - 1) & 15; const float f = 1e-4f + (float)j * ((15.0f - 1e-4f) / 15.0f); feat = F.lane <= 16 ? cosf(f * w) : -sinf(f * w); }
        const float* W1 = F.in[IN_HW1] + (size_t)l * 33 * 64; const float* W2 = F.in[IN_HW2] + (size_t)l * 64 * 64;
        float a = F.in[IN_HB1][l * 64 + F.lane];
#pragma unroll
        for (int f = 0; f < 33; ++f) a = fmaf(__shfl(feat, f), W1[f * 64 + F.lane], a);
        const float h1 = sinf(a);
        float b = F.in[IN_HB2][l * 64 + F.lane];
#pragma unroll 8
        for (int k = 0; k < 64; ++k) b = fmaf(__shfl(h1, k), W2[k * 64 + F.lane], b);
        const float h2 = sinf(b);
        float* dst = type ? WSP(float, WS_H2C) + (size_t)i * 64 : WSP(float, WS_H2) + ((size_t)l * 2048 + i) * 64;
        dst[F.lane] = h2;
    }
}
__device__ __forceinline__ void p1_mod(const Frame& F) {
    for (int e = F.bid * NTHR + F.tid; e < 2 * 9 * NMODC; e += F.G * NTHR) {
        const int l = e / (9 * NMODC), rem = e % (9 * NMODC), r = rem / NMODC, j = rem % NMODC;
        float s = F.in[IN_ADAB][l * NMODC + j];
#pragma unroll
        for (int kc = 0; kc < 8; ++kc) s += WSP(float, WS_MODP)[((size_t)(l * 8 + kc) * 9 + r) * NMODC + j];
        WSP(float, WS_MOD)[e] = s;
    }
}
__device__ __forceinline__ void p1_taps(const Frame& F) {
    LAS float* wl = (LAS float*)(F.lds + F.wave * 8192);
    for (int it = F.gw; it < 4096 + 256; it += F.NGW) {
        const int type = it < 4096 ? 0 : 1, r = type ? it - 4096 : it, l = type ? 0 : r >> 11, ib = type ? r >> 6 : (r >> 6) & 31, cbk = r & 63, o = cbk >> 5, c0 = (cbk & 31) * 16, n = type ? 256 : 2048;
        const int i = ib * 64 + F.lane;
        const float* h2 = (type ? WSP(float, WS_H2C) : WSP(float, WS_H2) + (size_t)l * 2048 * 64) + (size_t)i * 64;
        f32x4 hv[16];
#pragma unroll
        for (int q = 0; q < 16; ++q) hv[q] = *((const f32x4*)h2 + q);
        const float* W3 = F.in[IN_HW3] + (size_t)l * 64 * 2048 + (size_t)F.lane * 2048 + o * 512 + c0;
#pragma unroll
        for (int dir = 0; dir < 2; ++dir)
#pragma unroll
            for (int q = 0; q < 4; ++q) { const f32x4 w = *((const f32x4*)(W3 + dir * 1024) + q);
#pragma unroll
                for (int e = 0; e < 4; ++e) wl[(dir * 16 + q * 4 + e) * 64 + F.lane] = w[e]; }
        LDS_WAIT(); asm volatile("" ::: "memory");
        const float t = (float)i / (float)(n - 1);
        const float dmin = -3.0701134573f, dmax = -15.350567286f;
        for (int cc = 0; cc < 16; ++cc) {
            float sf = 0.f, sb = 0.f;
            const LAS f32x4* wf = (const LAS f32x4*)(wl + cc * 64); const LAS f32x4* wb = (const LAS f32x4*)(wl + (16 + cc) * 64);
#pragma unroll
            for (int q = 0; q < 16; ++q) { const f32x4 a = wf[q], bq = wb[q], h = hv[q];
                sf = fmaf(h[0], a[0], sf); sf = fmaf(h[1], a[1], sf); sf = fmaf(h[2], a[2], sf); sf = fmaf(h[3], a[3], sf);
                sb = fmaf(h[0], bq[0], sb); sb = fmaf(h[1], bq[1], sb); sb = fmaf(h[2], bq[2], sb); sb = fmaf(h[3], bq[3], sb); }
            const int c = c0 + cc;
            const float delta = fabsf(dmin + (float)c * ((dmax - dmin) / 511.0f)), win = expf(-t * delta) + 0.05f;
            float* dst = type ? WSP(float, WS_TAPSC) + ((size_t)o * 512 + c) * 512 : WSP(float, WS_TAPS) + (((size_t)l * 2 + o) * 512 + c) * 4096;
            if (i == 0) { dst[0] = (sf + sb) * win; dst[n] = 0.f; } else { dst[i] = sf * win; dst[2 * n - i] = sb * win; }
        }
        LDS_WAIT(); asm volatile("" ::: "memory");
    }
}

__device__ __forceinline__ void norm_row(const Frame& F, int row, const float* srcx, const float* srcc, const float* modl, int shift_idx, int scale_idx, bf16_t* dst, const float* part, const float* pgate, float* xout, float pcoef) {
    const float* xr = row < TX ? srcx + (size_t)row * DM : srcc + (size_t)(row - TX) * DM;
    const int mrow = row < TX ? row >> 11 : 8;
    const f32x4* xv = (const f32x4*)xr + F.lane;
    f32x4 v[8]; float ss = 0.f;
#pragma unroll
    for (int j = 0; j < 8; ++j) { v[j] = xv[64 * j]; ss += (v[j][0] * v[j][0] + v[j][1] * v[j][1]) + (v[j][2] * v[j][2] + v[j][3] * v[j][3]); }
    if (part && row >= TX) {
        const f32x4* pp = (const f32x4*)(part + (size_t)(row - TX) * DM) + F.lane; const f32x4* gp = (const f32x4*)pgate + F.lane; f32x4* xo = (f32x4*)(xout + (size_t)(row - TX) * DM) + F.lane;
        ss = 0.f;
#pragma unroll
        for (int j = 0; j < 8; ++j) { const f32x4 s4 = (pp[64 * j] + pp[64 * j + (size_t)TC * DM / 4]) + (pp[64 * j + (size_t)2 * TC * DM / 4] + pp[64 * j + (size_t)3 * TC * DM / 4]);
            v[j] = v[j] + gp[64 * j] * pcoef * s4; xo[64 * j] = v[j]; ss += (v[j][0] * v[j][0] + v[j][1] * v[j][1]) + (v[j][2] * v[j][2] + v[j][3] * v[j][3]); }
    }
    const float rstd = 1.0f / sqrtf(wave_sum(ss) * (1.0f / DM) + EPS);
    const f32x4* sh = (const f32x4*)(modl + (size_t)mrow * NMODC + shift_idx * DM) + F.lane;
    const f32x4* sc = (const f32x4*)(modl + (size_t)mrow * NMODC + scale_idx * DM) + F.lane;
    v2u* o = (v2u*)(dst + (size_t)row * DM) + F.lane;
#pragma unroll
    for (int j = 0; j < 8; ++j) { const f32x4 s = sh[64 * j], c = sc[64 * j]; const f32x4 y = v[j] * rstd * (c + 1.0f) + s;
        v2u w; w.x = pk2(y[0], y[1]); w.y = pk2(y[2], y[3]); o[64 * j] = w; }
}
__device__ __forceinline__ void norm_phase(const Frame& F, const float* srcx, const float* srcc, int nrows, const float* modl, int shift_idx, int scale_idx, bf16_t* dst, const float* part, const float* pgate, float* xout, float pcoef = 0.5f) {
    if (part) {
        for (int r0 = F.bid * 8; r0 < TC; r0 += F.G * 8) {
            const f32x4* pp = (const f32x4*)(part + (size_t)r0 * DM); const f32x4* sc4 = (const f32x4*)(srcc + (size_t)r0 * DM); f32x4* xo = (f32x4*)(xout + (size_t)r0 * DM); const f32x4* gp = (const f32x4*)pgate;
#pragma unroll
            for (int k = 0; k < 8; ++k) { const int idx = F.tid + NTHR * k;
                const f32x4 s4 = (pp[idx] + pp[idx + (size_t)TC * DM / 4]) + (pp[idx + (size_t)2 * TC * DM / 4] + pp[idx + (size_t)3 * TC * DM / 4]);
                xo[idx] = sc4[idx] + gp[idx & 511] * pcoef * s4; }
            VM_WAIT(); __syncthreads();
            norm_row(F, TX + r0 + F.wave, srcx, xout, modl, shift_idx, scale_idx, dst, nullptr, nullptr, nullptr, 0.f);
        }
        if (nrows > TX) nrows = TX;
        part = nullptr;
    }
    for (int row = F.gw; row < nrows; row += 2 * F.NGW) {
        const int row2 = row + F.NGW;
        if (row2 < nrows && !(part && row2 >= TX) && !(part && row >= TX)) {
            const float* xa = row < TX ? srcx + (size_t)row * DM : srcc + (size_t)(row - TX) * DM; const float* xb = row2 < TX ? srcx + (size_t)row2 * DM : srcc + (size_t)(row2 - TX) * DM;
            const int ma = row < TX ? row >> 11 : 8, mb = row2 < TX ? row2 >> 11 : 8;
            const f32x4* xva = (const f32x4*)xa + F.lane; const f32x4* xvb = (const f32x4*)xb + F.lane;
            f32x4 va[8], vb[8]; float sa = 0.f, sb = 0.f;
#pragma unroll
            for (int j = 0; j < 8; ++j) { va[j] = xva[64 * j]; vb[j] = xvb[64 * j]; }
#pragma unroll
            for (int j = 0; j < 8; ++j) { sa += (va[j][0] * va[j][0] + va[j][1] * va[j][1]) + (va[j][2] * va[j][2] + va[j][3] * va[j][3]); sb += (vb[j][0] * vb[j][0] + vb[j][1] * vb[j][1]) + (vb[j][2] * vb[j][2] + vb[j][3] * vb[j][3]); }
            const float ra = 1.0f / sqrtf(wave_sum(sa) * (1.0f / DM) + EPS), rb = 1.0f / sqrtf(wave_sum(sb) * (1.0f / DM) + EPS);
            const f32x4* sha = (const f32x4*)(modl + (size_t)ma * NMODC + shift_idx * DM) + F.lane; const f32x4* sca = (const f32x4*)(modl + (size_t)ma * NMODC + scale_idx * DM) + F.lane;
            const f32x4* shb = (const f32x4*)(modl + (size_t)mb * NMODC + shift_idx * DM) + F.lane; const f32x4* scb = (const f32x4*)(modl + (size_t)mb * NMODC + scale_idx * DM) + F.lane;
            v2u* oa = (v2u*)(dst + (size_t)row * DM) + F.lane; v2u* ob = (v2u*)(dst + (size_t)row2 * DM) + F.lane;
#pragma unroll
            for (int j = 0; j < 8; ++j) { const f32x4 ya = va[j] * ra * (sca[64 * j] + 1.0f) + sha[64 * j], yb = vb[j] * rb * (scb[64 * j] + 1.0f) + shb[64 * j];
                v2u w; w.x = pk2(ya[0], ya[1]); w.y = pk2(ya[2], ya[3]); oa[64 * j] = w; w.x = pk2(yb[0], yb[1]); w.y = pk2(yb[2], yb[3]); ob[64 * j] = w; }
        } else {
            norm_row(F, row, srcx, srcc, modl, shift_idx, scale_idx, dst, part, pgate, xout, pcoef);
            if (row2 < nrows) norm_row(F, row2, srcx, srcc, modl, shift_idx, scale_idx, dst, part, pgate, xout, pcoef);
        }
    }
}

__device__ __forceinline__ float rope_invfreq(int i) { return powf(10000.0f, -(float)i / 16.0f); }
__device__ __forceinline__ void postproj_phase(const Frame& F, int l) {
    const bf16_t* Z = WSP(bf16_t, WS_Z);
    const float* gkv = F.in[IN_KVNORM] + l * 256; const float* gq = F.in[IN_QNORM] + l * 512; const float* gkr = F.in[IN_KNROPE] + l * 64;
    for (int row = F.gw; row < TT; row += F.NGW) {
        const bf16_t* zr = Z + (size_t)row * ZLD;
        {
            const v2u w = *((const v2u*)(zr + ZC_KV) + F.lane);
            const float a0 = bflo(w.x), a1 = bfhi(w.x), a2 = bflo(w.y), a3 = bfhi(w.y);
            const float rstd = 1.0f / sqrtf(wave_sum(a0 * a0 + a1 * a1 + a2 * a2 + a3 * a3) * (1.0f / 256.0f) + EPS);
            const f32x4 g = *((const f32x4*)gkv + F.lane);
            v2u o; o.x = pk2(a0 * rstd * g[0], a1 * rstd * g[1]); o.y = pk2(a2 * rstd * g[2], a3 * rstd * g[3]);
            *((v2u*)(WSP(bf16_t, WS_KVN) + (size_t)row * 256) + F.lane) = o;
        }
        {
            const v4u w = *((const v4u*)(zr + ZC_Q) + F.lane);
            float a[8] = {bflo(w.x), bfhi(w.x), bflo(w.y), bfhi(w.y), bflo(w.z), bfhi(w.z), bflo(w.w), bfhi(w.w)};
            float ss = 0.f;
#pragma unroll
            for (int j = 0; j < 8; ++j) ss += a[j] * a[j];
            const float rstd = 1.0f / sqrtf(wave_sum(ss) * (1.0f / 512.0f) + EPS);
            const f32x4 g0 = *((const f32x4*)gq + 2 * F.lane), g1 = *((const f32x4*)gq + 2 * F.lane + 1);
            v4u o; o.x = pk2(a[0] * rstd * g0[0], a[1] * rstd * g0[1]); o.y = pk2(a[2] * rstd * g0[2], a[3] * rstd * g0[3]);
            o.z = pk2(a[4] * rstd * g1[0], a[5] * rstd * g1[1]); o.w = pk2(a[6] * rstd * g1[2], a[7] * rstd * g1[3]);
            *((v4u*)(WSP(bf16_t, WS_QN) + (size_t)row * 512) + F.lane) = o;
        }
        {
            const float a = bf1(zr[ZC_KR + F.lane]);
            const float rstd = 1.0f / sqrtf(wave_sum(a * a) * (1.0f / 64.0f) + EPS);
            float y = a * rstd * gkr[F.lane];
            if (row < TX) {
                const int t = row & (SEQ - 1), d = F.lane, within = d & 31, i = within & 15;
                const float pos = (float)((d >> 5) ? (t & 63) : (t >> 6));
                const float rev = pos * __builtin_amdgcn_exp2f((float)i * (-13.287712379549449f / 16.0f)) * 0.15915494309189535f;
                const float cs = __builtin_amdgcn_cosf(rev), sn = __builtin_amdgcn_sinf(rev);
                const float other = sx<16>(y);
                y = within < 16 ? y * cs - other * sn : other * sn + y * cs;
            }
            WSP(bf16_t, WS_KROPE)[(size_t)row * 64 + F.lane] = (bf16_t)f2bf(y);
        }
    }
}

constexpr float QSCALE = 0.07216878364870322f * 1.4426950408889634f;
__device__ __forceinline__ void headnorm_phase(const Frame& F, int l) {
    const float* gkn = F.in[IN_KNNOPE] + l * 128; const float* gqn = F.in[IN_QNNOPE] + l * 128; const float* gqr = F.in[IN_QNROPE] + l * 64; const float* gkr = F.in[IN_KNROPE] + l * 64;
    float m1 = fmaxf(fabsf(gkn[F.lane]), fabsf(gkn[64 + F.lane])), m2 = fabsf(gkr[F.lane]);
    m1 = wave_max(m1); m2 = wave_max(m2);
    const float kbound = 1.02f * sqrtf(128.0f * m1 * m1 + 64.0f * m2 * m2);
    const int nq = 0;
    const int h = F.lane >> 3, s8 = F.lane & 7;
    for (int row = F.gw; row < TT; row += F.NGW) {
        {
            v4u* kp = (v4u*)(WSP(bf16_t, WS_KV) + (size_t)row * 2048 + h * 256 + s8 * 16);
            const v4u w0 = kp[0], w1 = kp[1];
            float a[16] = {bflo(w0.x), bfhi(w0.x), bflo(w0.y), bfhi(w0.y), bflo(w0.z), bfhi(w0.z), bflo(w0.w), bfhi(w0.w),
                           bflo(w1.x), bfhi(w1.x), bflo(w1.y), bfhi(w1.y), bflo(w1.z), bfhi(w1.z), bflo(w1.w), bfhi(w1.w)};
            float ss = 0.f;
#pragma unroll
            for (int j = 0; j < 16; ++j) ss += a[j] * a[j];
            ss += sx<1>(ss); ss += sx<2>(ss); ss += sx<4>(ss);
            const float rstd = 1.0f / sqrtf(ss * (1.0f / 128.0f) + EPS);
            const float* g = gkn + s8 * 16;
            v4u o0, o1;
            o0.x = pk2(a[0] * rstd * g[0], a[1] * rstd * g[1]); o0.y = pk2(a[2] * rstd * g[2], a[3] * rstd * g[3]); o0.z = pk2(a[4] * rstd * g[4], a[5] * rstd * g[5]); o0.w = pk2(a[6] * rstd * g[6], a[7] * rstd * g[7]);
            o1.x = pk2(a[8] * rstd * g[8], a[9] * rstd * g[9]); o1.y = pk2(a[10] * rstd * g[10], a[11] * rstd * g[11]); o1.z = pk2(a[12] * rstd * g[12], a[13] * rstd * g[13]); o1.w = pk2(a[14] * rstd * g[14], a[15] * rstd * g[15]);
            kp[0] = o0; kp[1] = o1;
        }
        if (row < nq) {
            bf16_t* qrow = WSP(bf16_t, WS_Q) + (size_t)row * 1536 + h * 192;
            v4u* qp = (v4u*)(qrow + s8 * 16);
            const v4u w0 = qp[0], w1 = qp[1];
            float a[16] = {bflo(w0.x), bfhi(w0.x), bflo(w0.y), bfhi(w0.y), bflo(w0.z), bfhi(w0.z), bflo(w0.w), bfhi(w0.w),
                           bflo(w1.x), bfhi(w1.x), bflo(w1.y), bfhi(w1.y), bflo(w1.z), bfhi(w1.z), bflo(w1.w), bfhi(w1.w)};
            float ss = 0.f;
#pragma unroll
            for (int j = 0; j < 16; ++j) ss += a[j] * a[j];
            ss += sx<1>(ss); ss += sx<2>(ss); ss += sx<4>(ss);
            const float rstd = QSCALE / sqrtf(ss * (1.0f / 128.0f) + EPS);
            const float* g = gqn + s8 * 16;
            float qq = 0.f;
#pragma unroll
            for (int j = 0; j < 16; ++j) { a[j] = a[j] * rstd * g[j]; qq += a[j] * a[j]; }
            v4u o0, o1;
            o0.x = pk2(a[0], a[1]); o0.y = pk2(a[2], a[3]); o0.z = pk2(a[4], a[5]); o0.w = pk2(a[6], a[7]);
            o1.x = pk2(a[8], a[9]); o1.y = pk2(a[10], a[11]); o1.z = pk2(a[12], a[13]); o1.w = pk2(a[14], a[15]);
            qp[0] = o0; qp[1] = o1;
            v4u* rp = (v4u*)(qrow + 128 + s8 * 8);
            const v4u w = rp[0];
            float r[8] = {bflo(w.x), bfhi(w.x), bflo(w.y), bfhi(w.y), bflo(w.z), bfhi(w.z), bflo(w.w), bfhi(w.w)};
            float s2 = 0.f;
#pragma unroll
            for (int j = 0; j < 8; ++j) s2 += r[j] * r[j];
            s2 += sx<1>(s2); s2 += sx<2>(s2); s2 += sx<4>(s2);
            const float rstd2 = 1.0f / sqrtf(s2 * (1.0f / 64.0f) + EPS);
            const int t = row & (SEQ - 1);
#pragma unroll
            for (int j = 0; j < 8; ++j) {
                float y = r[j] * rstd2 * gqr[s8 * 8 + j];
                const float other = sx<2>(y);
                if (row < TX) {
                    const int d = s8 * 8 + j, within = d & 31, i = within & 15;
                    const float pos = (float)((d >> 5) ? (t & 63) : (t >> 6));
                    const float ang = pos * rope_invfreq(i);
                    const float cs = cosf(ang), sn = sinf(ang);
                    y = within < 16 ? y * cs - other * sn : other * sn + y * cs;
                }
                r[j] = y * QSCALE; qq += r[j] * r[j];
            }
            v4u o; o.x = pk2(r[0], r[1]); o.y = pk2(r[2], r[3]); o.z = pk2(r[4], r[5]); o.w = pk2(r[6], r[7]);
            rp[0] = o;
            qq += sx<1>(qq); qq += sx<2>(qq); qq += sx<4>(qq);
            if (s8 == 0) WSP(float, WS_BQ)[(size_t)row * 8 + h] = sqrtf(qq) * kbound;
        }
    }
}


__device__ __forceinline__ int key_row(bool isx, int b, int key) { return isx ? (key < CTXL ? TX + b * CTXL + key : b * SEQ + (key - CTXL)) : TX + b * CTXL + key; }

__device__ __forceinline__ float log2_gamma(const Frame& F, int l, int dir, int h) { const float x = F.in[IN_RDECAY][(l * 2 + dir) * 4 + h]; return -log1pf(expf(-x)) * 1.4426950408889634f; }

__device__ __forceinline__ void ret_naive(const Frame& F, int l) {
    LAS float* dl = (LAS float*)(F.lds + F.wave * 9216);
    const bf16_t* Z = WSP(bf16_t, WS_Z);
    const int nrows = (l == 0) ? TT : TX;
    for (int item = F.gw; item < nrows * 4; item += F.NGW) {
        const int row = item >> 2, h = item & 3; const bool isx = row < TX;
        const int b = isx ? row >> 11 : (row - TX) >> 8, nk = isx ? SEQ + CTXL : CTXL;
        const int tpos = isx ? (row & (SEQ - 1)) : ((row - TX) & (CTXL - 1));
        const v4u* qp = (const v4u*)(Z + (size_t)row * ZLD + ZC_RQ + h * 64);
        for (int i = 0; i < nk / 64; ++i) {
            const int key = i * 64 + F.lane, kr = key_row(isx, b, key);
            const v4u* kp = (const v4u*)(Z + (size_t)kr * ZLD + ZC_RK + h * 64);
            float s = 0.f;
#pragma unroll
            for (int c = 0; c < 8; ++c) s = dot8(qp[c], kp[c], s);
            dl[key] = s * 0.125f;
        }
        LDS_WAIT(); asm volatile("" ::: "memory");
        const float lgf = log2_gamma(F, l, 0, h), lgb = log2_gamma(F, l, 1, h);
        float f0 = 0.f, f1 = 0.f, b0 = 0.f, b1 = 0.f;
        for (int key = 0; key < nk; ++key) {
            const int kr = key_row(isx, b, key);
            const unsigned v2 = *((const unsigned*)(Z + (size_t)kr * ZLD + ZC_RV + h * 128) + F.lane);
            float wf = 0.f, wb = 0.f;
            if (isx) {
                if (key < CTXL) { wf = exp2f((float)(tpos + CTXL - key) * lgf); wb = exp2f((float)(SEQ - tpos + key) * lgb); }
                else { const int s = key - CTXL; if (s <= tpos) wf = exp2f((float)(tpos - s) * lgf); if (s >= tpos) wb = exp2f((float)(s - tpos) * lgb); }
            } else { if (key <= tpos) wf = exp2f((float)(tpos - key) * lgf); if (key >= tpos) wb = exp2f((float)(key - tpos) * lgb); }
            const float d = dl[key]; const float v0 = bflo(v2), v1 = bfhi(v2);
            f0 = fmaf(wf * d, v0, f0); f1 = fmaf(wf * d, v1, f1); b0 = fmaf(wb * d, v0, b0); b1 = fmaf(wb * d, v1, b1);
        }
        float* ro = WSP(float, WS_RO) + (size_t)row * 512 + h * 128 + 2 * F.lane;
        ro[0] = f0; ro[1] = f1; ro[(size_t)TT * 512] = b0; ro[(size_t)TT * 512 + 1] = b1;
        LDS_WAIT(); asm volatile("" ::: "memory");
    }
}

__device__ __forceinline__ void hyena_ctx(const Frame& F, int l) {
    if (l != 0) return;
    LAS float* base = (LAS float*)(F.lds + F.wave * 8192);
    LAS float* sin_ = base; LAS float* sy = base + 256; LAS float* tp = base + 512;
    const bf16_t* ZT = WSP(bf16_t, WS_ZT);
    const float* cw = F.in[IN_HCW]; const float* cb = F.in[IN_HCB]; const float* skip = F.in[IN_HSKIP];
    const int t0 = 4 * F.lane;
    for (int it = F.gw; it < NB * 512; it += F.NGW) {
        const int b = it >> 9, c = it & 511, col0 = TX + b * CTXL;
        float gx1[4], gx2[4], vv[4];
#pragma unroll
        for (int g = 0; g < 3; ++g) { const int j = g * 512 + c; const bf16_t* rp = ZT + (size_t)j * TT + col0;
            const v2u w = *(const v2u*)(rp + t0);
            const float u0 = bflo(w.x), u1 = bfhi(w.x), u2 = bflo(w.y), u3 = bfhi(w.y);
            const float um = t0 > 0 ? bf1(rp[t0 - 1]) : 0.f, up = t0 + 4 < CTXL ? bf1(rp[t0 + 4]) : 0.f;
            const float w0 = cw[j], w1 = cw[1536 + j], w2 = cw[2 * 1536 + j], bs = cb[j];
            float o[4] = {w0 * um + w1 * u0 + w2 * u1 + bs, w0 * u0 + w1 * u1 + w2 * u2 + bs, w0 * u1 + w1 * u2 + w2 * u3 + bs, w0 * u2 + w1 * u3 + w2 * up + bs};
#pragma unroll
            for (int e = 0; e < 4; ++e) { if (g == 0) gx1[e] = o[e]; else if (g == 1) gx2[e] = o[e]; else vv[e] = o[e]; } }
        *(LAS f32x4*)(sin_ + t0) = (f32x4){vv[0], vv[1], vv[2], vv[3]};
#pragma unroll
        for (int o = 0; o < 2; ++o) {
            const float* tg = WSP(float, WS_TAPSC) + ((size_t)o * 512 + c) * 512;
            *(LAS f32x4*)(tp + 8 * F.lane) = *(const f32x4*)(tg + 8 * F.lane); *(LAS f32x4*)(tp + 8 * F.lane + 4) = *(const f32x4*)(tg + 8 * F.lane + 4);
            LDS_WAIT(); asm volatile("" ::: "memory");
            const LAS float* in = o ? sy : sin_; const float sk = skip[o * 512 + c];
            float acc[4] = {0.f, 0.f, 0.f, 0.f};
#pragma unroll 4
            for (int m = 0; m < CTXL / 4; ++m) {
                const f32x4 u = *(const LAS f32x4*)(in + 4 * m);
                const int d0 = (t0 - 4 * m) & 511;
                const f32x4 hi = *(const LAS f32x4*)(tp + d0), lo = *(const LAS f32x4*)(tp + ((d0 - 4) & 511));
                const float w[7] = {lo[1], lo[2], lo[3], hi[0], hi[1], hi[2], hi[3]};
#pragma unroll
                for (int k = 0; k < 4; ++k)
#pragma unroll
                    for (int j = 0; j < 4; ++j) acc[k] = fmaf(w[3 + k - j], u[j], acc[k]);
            }
            const f32x4 iv = *(const LAS f32x4*)(in + t0);
            float y[4];
#pragma unroll
            for (int k = 0; k < 4; ++k) y[k] = (o ? gx2[k] : gx1[k]) * (acc[k] + sk * iv[k]);
            LDS_WAIT(); asm volatile("" ::: "memory");
            if (o == 0) *(LAS f32x4*)(sy + t0) = (f32x4){y[0], y[1], y[2], y[3]};
            else *(f32x4*)(WSP(float, WS_HY) + (size_t)c * TT + col0 + t0) = (f32x4){y[0], y[1], y[2], y[3]};
            LDS_WAIT(); asm volatile("" ::: "memory");
        }
    }
}

__device__ __forceinline__ void merge_phase(const Frame& F, int l) {
    const int nrows = (l == 0) ? TT : TX;
    LAS float* hy_s = (LAS float*)F.lds;
    const float* gout = F.in[IN_OUTNORM] + l * 1024; const float* ghy = F.in[IN_HONORM] + l * 512; const float* gnw = F.in[IN_RGNW] + l * 512; const float* gnb = F.in[IN_RGNB] + l * 512;
    for (int tile = F.bid; tile < nrows / 32; tile += F.G) {
      __syncthreads();
      { const f32x4* hp = (const f32x4*)(WSP(float, WS_HY) + (size_t)F.tid * TT + tile * 32);
#pragma unroll
        for (int q = 0; q < 8; ++q) { const f32x4 v = hp[q];
#pragma unroll
            for (int e = 0; e < 4; ++e) hy_s[F.tid * 33 + 4 * q + e] = v[e]; } }
      __syncthreads();
#pragma unroll
      for (int r4 = 0; r4 < 4; ++r4) {
        const int rr = 4 * F.wave + r4, row = tile * 32 + rr;
        bf16_t* mr = WSP(bf16_t, WS_HMOD) + (size_t)row * DM;
        {
            const v4u* ap = (const v4u*)(WSP(bf16_t, WS_AO) + (size_t)row * 1024 + F.lane * 16);
            const v4u w0 = ap[0], w1 = ap[1];
            float a[16] = {bflo(w0.x), bfhi(w0.x), bflo(w0.y), bfhi(w0.y), bflo(w0.z), bfhi(w0.z), bflo(w0.w), bfhi(w0.w),
                           bflo(w1.x), bfhi(w1.x), bflo(w1.y), bfhi(w1.y), bflo(w1.z), bfhi(w1.z), bflo(w1.w), bfhi(w1.w)};
            float ss = 0.f;
#pragma unroll
            for (int j = 0; j < 16; ++j) ss += a[j] * a[j];
            const float rstd = 1.0f / sqrtf(wave_sum(ss) * (1.0f / 1024.0f) + EPS);
            const float* g = gout + F.lane * 16;
            v4u o0, o1;
            o0.x = pk2(a[0] * rstd * g[0], a[1] * rstd * g[1]); o0.y = pk2(a[2] * rstd * g[2], a[3] * rstd * g[3]); o0.z = pk2(a[4] * rstd * g[4], a[5] * rstd * g[5]); o0.w = pk2(a[6] * rstd * g[6], a[7] * rstd * g[7]);
            o1.x = pk2(a[8] * rstd * g[8], a[9] * rstd * g[9]); o1.y = pk2(a[10] * rstd * g[10], a[11] * rstd * g[11]); o1.z = pk2(a[12] * rstd * g[12], a[13] * rstd * g[13]); o1.w = pk2(a[14] * rstd * g[14], a[15] * rstd * g[15]);
            v4u* op = (v4u*)(mr + F.lane * 16); op[0] = o0; op[1] = o1;
        }
        {
            float a[8]; float ss = 0.f;
#pragma unroll
            for (int j = 0; j < 8; ++j) { a[j] = hy_s[(F.lane + 64 * j) * 33 + rr]; ss += a[j] * a[j]; }
            const float rstd = 1.0f / sqrtf(wave_sum(ss) * (1.0f / 512.0f) + EPS);
#pragma unroll
            for (int j = 0; j < 8; ++j) mr[1024 + F.lane + 64 * j] = (bf16_t)f2bf(a[j] * rstd * ghy[F.lane + 64 * j]);
        }
        {
            const float* r0 = WSP(float, WS_RO) + (size_t)row * 512 + F.lane * 8; const float* r1 = r0 + (size_t)TT * 512;
            const f32x4 x0 = *(const f32x4*)r0 + *(const f32x4*)r1, x1 = *((const f32x4*)r0 + 1) + *((const f32x4*)r1 + 1);
            float a[8] = {x0[0], x0[1], x0[2], x0[3], x1[0], x1[1], x1[2], x1[3]};
            float s = 0.f;
#pragma unroll
            for (int j = 0; j < 8; ++j) s += a[j];
            s += sx<1>(s); s += sx<2>(s); s += sx<4>(s); s += sx<8>(s);
            const float mu = s * (1.0f / 128.0f); float q = 0.f;
#pragma unroll
            for (int j = 0; j < 8; ++j) { a[j] -= mu; q += a[j] * a[j]; }
            q += sx<1>(q); q += sx<2>(q); q += sx<4>(q); q += sx<8>(q);
            const float rstd = 1.0f / sqrtf(q * (1.0f / 128.0f) + EPS);
            const v4u gw = *((const v4u*)(WSP(bf16_t, WS_Z) + (size_t)row * ZLD + ZC_RG) + F.lane);
            const float gt[8] = {bflo(gw.x), bfhi(gw.x), bflo(gw.y), bfhi(gw.y), bflo(gw.z), bfhi(gw.z), bflo(gw.w), bfhi(gw.w)};
            float y[8];
#pragma unroll
            for (int j = 0; j < 8; ++j) { const float o = a[j] * rstd * gnw[F.lane * 8 + j] + gnb[F.lane * 8 + j]; const float gg = gt[j]; y[j] = gg / (1.0f + expf(-gg)) * o; }
            v4u o; o.x = pk2(y[0], y[1]); o.y = pk2(y[2], y[3]); o.z = pk2(y[4], y[5]); o.w = pk2(y[6], y[7]);
            *((v4u*)(mr + 1536) + F.lane) = o;
        }
      }
    }
    __syncthreads();
}

namespace att {
typedef short bf16x8 __attribute__((ext_vector_type(8)));
typedef short s16x4 __attribute__((ext_vector_type(4)));
typedef float f32x16 __attribute__((ext_vector_type(16)));
typedef unsigned u32x4 __attribute__((ext_vector_type(4)));
constexpr int KROW = 400;
constexpr int SHM_K = 64 * KROW, SHM_V = 64 * 128 * 2;
constexpr int OFF_V = 0, OFF_K = 2 * SHM_V, OFF_WS = OFF_K + 2 * SHM_K, ATT_LDS = OFF_WS + 8 * 256;
static_assert(ATT_LDS <= RING_BYTES, "attention LDS");
#define ATT_SBAR() __builtin_amdgcn_sched_barrier(0)
__device__ __forceinline__ int crow(int r, int hi) { return (r & 3) + 8 * (r >> 2) + 4 * hi; }
__device__ __forceinline__ unsigned cvtpk(float lo, float hi) { unsigned r; asm volatile("v_cvt_pk_bf16_f32 %0, %1, %2" : "=v"(r) : "v"(lo), "v"(hi)); return r; }
__device__ __forceinline__ int v_st(int k, int c) { const int kk = (k & ~0xC) | ((k & 4) << 1) | ((k & 8) >> 1); return ((kk >> 3) * 4 + (c >> 5)) * 512 + ((kk & 7) * 32 + (c & 31)) * 2; }
__device__ __forceinline__ int v_rd_base(int lane) { return ((lane & 3) << 3) | (((lane >> 2) & 3) << 6) | (((lane >> 4) & 1) << 5) | (((lane >> 5) & 1) << 8); }
constexpr int v_rd_off(int d0, int ks, int half) { return d0 * 512 + ks * 4096 + half * 2048; }
template <int OFF> __device__ __forceinline__ s16x4 tr_read(int vb) { s16x4 r; asm volatile("ds_read_b64_tr_b16 %0, %1 offset:%2" : "=&v"(r) : "v"(vb), "i"(OFF) : "memory"); return r; }
template <int D0> __device__ __forceinline__ void pv_one(f32x16& od, int vb, bf16x8 pa0, bf16x8 pa1, bf16x8 pa2, bf16x8 pa3) {
    const s16x4 l0 = tr_read<v_rd_off(D0, 0, 0)>(vb), h0 = tr_read<v_rd_off(D0, 0, 1)>(vb), l1 = tr_read<v_rd_off(D0, 1, 0)>(vb), h1 = tr_read<v_rd_off(D0, 1, 1)>(vb);
    const s16x4 l2 = tr_read<v_rd_off(D0, 2, 0)>(vb), h2 = tr_read<v_rd_off(D0, 2, 1)>(vb), l3 = tr_read<v_rd_off(D0, 3, 0)>(vb), h3 = tr_read<v_rd_off(D0, 3, 1)>(vb);
    asm volatile("s_waitcnt lgkmcnt(0)" ::: "memory"); ATT_SBAR();
#define ATT_PK(L, H) (bf16x8){L[0], L[1], L[2], L[3], H[0], H[1], H[2], H[3]}
    od = __builtin_amdgcn_mfma_f32_32x32x16_bf16(pa0, ATT_PK(l0, h0), od, 0, 0, 0);
    od = __builtin_amdgcn_mfma_f32_32x32x16_bf16(pa1, ATT_PK(l1, h1), od, 0, 0, 0);
    od = __builtin_amdgcn_mfma_f32_32x32x16_bf16(pa2, ATT_PK(l2, h2), od, 0, 0, 0);
    od = __builtin_amdgcn_mfma_f32_32x32x16_bf16(pa3, ATT_PK(l3, h3), od, 0, 0, 0);
#undef ATT_PK
}
template <int OFF> __device__ __forceinline__ bf16x8 lds_read128(int addr) { bf16x8 r; asm volatile("ds_read_b128 %0, %1 offset:%2" : "=&v"(r) : "v"(addr), "i"(OFF) : "memory"); return r; }
__device__ __forceinline__ void qkt(f32x16& p0, f32x16& p1, float negB, int kaddr, const bf16x8 (&qr)[12]) {
#pragma unroll
    for (int r = 0; r < 16; ++r) { p0[r] = negB; p1[r] = negB; }
    constexpr int B0 = 0, B1 = 32 * KROW;
    bf16x8 a0[3], a1[3], c0[3], c1[3];
#define ATT_LDG(X0, X1, G) do { X0[0] = lds_read128<B0 + (3 * (G) + 0) * 32>(kaddr); X1[0] = lds_read128<B1 + (3 * (G) + 0) * 32>(kaddr); X0[1] = lds_read128<B0 + (3 * (G) + 1) * 32>(kaddr); \
        X1[1] = lds_read128<B1 + (3 * (G) + 1) * 32>(kaddr); X0[2] = lds_read128<B0 + (3 * (G) + 2) * 32>(kaddr); X1[2] = lds_read128<B1 + (3 * (G) + 2) * 32>(kaddr); } while (0)
#define ATT_MMG(X0, X1, G) do { _Pragma("unroll") for (int i = 0; i < 3; ++i) { p0 = __builtin_amdgcn_mfma_f32_32x32x16_bf16(X0[i], qr[3 * (G) + i], p0, 0, 0, 0); \
        p1 = __builtin_amdgcn_mfma_f32_32x32x16_bf16(X1[i], qr[3 * (G) + i], p1, 0, 0, 0); } } while (0)
    ATT_LDG(a0, a1, 0);
    ATT_LDG(c0, c1, 1); asm volatile("s_waitcnt lgkmcnt(6)" ::: "memory"); ATT_SBAR(); ATT_MMG(a0, a1, 0); ATT_SBAR();
    ATT_LDG(a0, a1, 2); asm volatile("s_waitcnt lgkmcnt(6)" ::: "memory"); ATT_SBAR(); ATT_MMG(c0, c1, 1); ATT_SBAR();
    ATT_LDG(c0, c1, 3); asm volatile("s_waitcnt lgkmcnt(6)" ::: "memory"); ATT_SBAR(); ATT_MMG(a0, a1, 2); ATT_SBAR();
    asm volatile("s_waitcnt lgkmcnt(0)" ::: "memory"); ATT_SBAR(); ATT_MMG(c0, c1, 3); ATT_SBAR();
#undef ATT_LDG
#undef ATT_MMG
}
__device__ __forceinline__ void softmax_pack(f32x16& p0, f32x16& p1, float& l_reg, bf16x8& pa0, bf16x8& pa1, bf16x8& pa2, bf16x8& pa3) {
#pragma unroll
    for (int r = 0; r < 16; ++r) { p0[r] = __builtin_amdgcn_exp2f(p0[r]); p1[r] = __builtin_amdgcn_exp2f(p1[r]); }
    float ps = 0.f;
#pragma unroll
    for (int r = 0; r < 16; ++r) ps += p0[r] + p1[r];
    l_reg += ps;
#define ATT_PK4(P, BASE, OUT) do { unsigned a0 = cvtpk(P[BASE + 0], P[BASE + 1]), a1 = cvtpk(P[BASE + 2], P[BASE + 3]);   \
    unsigned b0 = cvtpk(P[BASE + 4], P[BASE + 5]), b1 = cvtpk(P[BASE + 6], P[BASE + 7]);                              \
    auto r0 = __builtin_amdgcn_permlane32_swap(a0, b0, false, false); auto r1 = __builtin_amdgcn_permlane32_swap(a1, b1, false, false); \
    u32x4 w = {r0[0], r1[0], r0[1], r1[1]}; OUT = *reinterpret_cast<bf16x8*>(&w); } while (0)
    ATT_PK4(p0, 0, pa0); ATT_PK4(p0, 8, pa1); ATT_PK4(p1, 0, pa2); ATT_PK4(p1, 8, pa3);
#undef ATT_PK4
}
__device__ __forceinline__ void v_inv(int x, int& k, int& c) { const int sub = x >> 9, within = x & 511, kk = (sub >> 2) * 8 + (within >> 6); k = (kk & ~0xC) | ((kk & 4) << 1) | ((kk & 8) >> 1); c = (sub & 3) * 32 + ((within & 63) >> 1); }

__device__ __forceinline__ void attn_unit(const bf16_t* Qb, const float* gqn, const float* gqr, float kbound, int tpos0, const bf16_t* KVh, const bf16_t* KR, bf16_t* Ob, int rowc, int rowx, int NT, LAS char* lds, int tid_in) {
    int tid = tid_in; asm volatile("" : "+v"(tid));
    const int wid = __builtin_amdgcn_readfirstlane(tid >> 6), lane = tid & 63, r32 = lane & 31, hi = lane >> 5;
    LAS float* li_l = (LAS float*)(lds + OFF_WS + wid * 256);
    float l_reg = 0.f; f32x16 o[4];
#pragma unroll
    for (int d = 0; d < 4; ++d)
#pragma unroll
        for (int r = 0; r < 16; ++r) o[d][r] = 0.f;
    bf16x8 qr[12];
    { const bf16_t* Qw = Qb + (size_t)(wid * 32 + r32) * 1536 + hi * 8;
#pragma unroll
      for (int d0 = 0; d0 < 12; ++d0) qr[d0] = *(const bf16x8*)(Qw + d0 * 16); }
    float negB;
    {   LAS float* xs = (LAS float*)(lds + OFF_WS + wid * 256);
        float ssn = 0.f, ssr = 0.f;
#pragma unroll
        for (int d0 = 0; d0 < 12; ++d0)
#pragma unroll
            for (int j = 0; j < 8; ++j) { const float x = bf1((bf16_t)qr[d0][j]); if (d0 < 8) ssn += x * x; else ssr += x * x; }
        xs[lane] = ssn; asm volatile("s_waitcnt lgkmcnt(0)" ::: "memory"); ssn += xs[lane ^ 32]; asm volatile("s_waitcnt lgkmcnt(0)" ::: "memory");
        xs[lane] = ssr; asm volatile("s_waitcnt lgkmcnt(0)" ::: "memory"); ssr += xs[lane ^ 32]; asm volatile("s_waitcnt lgkmcnt(0)" ::: "memory");
        const float rn = QSCALE / sqrtf(ssn * (1.0f / 128.0f) + EPS), rr = 1.0f / sqrtf(ssr * (1.0f / 64.0f) + EPS);
        float qq = 0.f;
#pragma unroll
        for (int d0 = 0; d0 < 8; ++d0) { const f32x4 g0 = *(const f32x4*)(gqn + d0 * 16 + hi * 8), g1 = *(const f32x4*)(gqn + d0 * 16 + hi * 8 + 4);
#pragma unroll
            for (int j = 0; j < 8; ++j) { const float y = bf1((bf16_t)qr[d0][j]) * rn * (j < 4 ? g0[j & 3] : g1[j & 3]); qq += y * y; qr[d0][j] = (short)f2bf(y); } }
        const int t = tpos0 + wid * 32 + r32;
#pragma unroll
        for (int seg = 0; seg < 2; ++seg) { const int a = 8 + 2 * seg; const float pos = (float)(seg ? (t & 63) : (t >> 6));
            const f32x4 ga0 = *(const f32x4*)(gqr + (a - 8) * 16 + hi * 8), ga1 = *(const f32x4*)(gqr + (a - 8) * 16 + hi * 8 + 4), gb0 = *(const f32x4*)(gqr + (a - 7) * 16 + hi * 8), gb1 = *(const f32x4*)(gqr + (a - 7) * 16 + hi * 8 + 4);
#pragma unroll
            for (int j = 0; j < 8; ++j) {
                const float x1 = bf1((bf16_t)qr[a][j]) * rr * (j < 4 ? ga0[j & 3] : ga1[j & 3]), x2 = bf1((bf16_t)qr[a + 1][j]) * rr * (j < 4 ? gb0[j & 3] : gb1[j & 3]);
                float y1 = x1, y2 = x2;
                if (tpos0 >= 0) { const float rev = pos * __builtin_amdgcn_exp2f((float)(hi * 8 + j) * (-13.287712379549449f / 16.0f)) * 0.15915494309189535f;
                    const float cs = __builtin_amdgcn_cosf(rev), sn = __builtin_amdgcn_sinf(rev); y1 = x1 * cs - x2 * sn; y2 = x1 * sn + x2 * cs; }
                y1 *= QSCALE; y2 *= QSCALE; qq += y1 * y1 + y2 * y2;
                qr[a][j] = (short)f2bf(y1); qr[a + 1][j] = (short)f2bf(y2); } }
        xs[lane] = qq; asm volatile("s_waitcnt lgkmcnt(0)" ::: "memory"); qq += xs[lane ^ 32]; asm volatile("s_waitcnt lgkmcnt(0)" ::: "memory");
        negB = -sqrtf(qq) * kbound;
    }
    unsigned vsrc[2], ksrc[4]; bool krope[4];
#pragma unroll
    for (int i = 0; i < 2; ++i) { int k, c; v_inv((wid * 2 + i) * 1024 + lane * 16, k, c); vsrc[i] = (unsigned)(k * 4096 + (128 + c) * 2); }
#pragma unroll
    for (int i = 0; i < 4; ++i) { const int x = (wid + 8 * i) * 1024 + lane * 16, row = x / KROW, cb = x % KROW;
        krope[i] = (cb >= 256 && cb < 384); ksrc[i] = krope[i] ? (unsigned)(row * 128 + (cb - 256)) : (unsigned)(row * 4096 + (cb < 256 ? cb : 0)); }
    const int kaddr = (int)(unsigned)(size_t)lds + OFF_K + r32 * KROW + hi * 16;
    const int vb0 = (int)(unsigned)(size_t)lds + OFF_V + v_rd_base(lane);
#define ATT_ISSUE(BUF, t) do { const int row0_ = (t) < 4 ? rowc + 64 * (t) : rowx + 64 * ((t) - 4); \
        const char* kvb_ = (const char*)KVh + (size_t)row0_ * 4096; const char* krb_ = (const char*)KR + (size_t)row0_ * 128; \
        _Pragma("unroll") for (int i_ = 0; i_ < 2; ++i_) __builtin_amdgcn_global_load_lds((const unsigned*)(kvb_ + vsrc[i_]), (LAS unsigned*)(lds + OFF_V + (BUF) * SHM_V + (wid * 2 + i_) * 1024), 16, 0, 0); \
        _Pragma("unroll") for (int i_ = 0; i_ < 3; ++i_) __builtin_amdgcn_global_load_lds((const unsigned*)((krope[i_] ? krb_ : kvb_) + ksrc[i_]), (LAS unsigned*)(lds + OFF_K + (BUF) * SHM_K + (wid + 8 * i_) * 1024), 16, 0, 0); \
        if (wid == 0) __builtin_amdgcn_global_load_lds((const unsigned*)((krope[3] ? krb_ : kvb_) + ksrc[3]), (LAS unsigned*)(lds + OFF_K + (BUF) * SHM_K + 24 * 1024), 16, 0, 0); } while (0)
#define ATT_TILE_DONE() do { asm volatile("s_waitcnt vmcnt(0)" ::: "memory"); __builtin_amdgcn_s_barrier(); asm volatile("" ::: "memory"); } while (0)
    f32x16 p0, p1; bf16x8 pa0, pa1, pa2, pa3;
    ATT_ISSUE(0, 0); ATT_TILE_DONE();
    for (int j = 0; j < NT; j += 2) {
        ATT_ISSUE(1, j + 1);
        ATT_SBAR(); qkt(p0, p1, negB, kaddr, qr);
        softmax_pack(p0, p1, l_reg, pa0, pa1, pa2, pa3); ATT_SBAR();
        pv_one<0>(o[0], vb0, pa0, pa1, pa2, pa3); pv_one<1>(o[1], vb0, pa0, pa1, pa2, pa3); pv_one<2>(o[2], vb0, pa0, pa1, pa2, pa3); pv_one<3>(o[3], vb0, pa0, pa1, pa2, pa3);
        ATT_TILE_DONE();
        if (j + 2 < NT) ATT_ISSUE(0, j + 2);
        ATT_SBAR(); qkt(p0, p1, negB, kaddr + SHM_K, qr);
        softmax_pack(p0, p1, l_reg, pa0, pa1, pa2, pa3); ATT_SBAR();
        pv_one<0>(o[0], vb0 + SHM_V, pa0, pa1, pa2, pa3); pv_one<1>(o[1], vb0 + SHM_V, pa0, pa1, pa2, pa3); pv_one<2>(o[2], vb0 + SHM_V, pa0, pa1, pa2, pa3); pv_one<3>(o[3], vb0 + SHM_V, pa0, pa1, pa2, pa3);
        ATT_TILE_DONE();
    }
#undef ATT_ISSUE
#undef ATT_TILE_DONE
    li_l[lane] = l_reg;
    asm volatile("s_waitcnt lgkmcnt(0)" ::: "memory");
    int lane2 = lane; asm volatile("" : "+v"(lane2));
    const int r32e = lane2 & 31, hie = lane2 >> 5;
    LAS char* st = lds + wid * (32 * 272);
#pragma unroll
    for (int r = 0; r < 16; ++r) { const int orow = (r & 3) + 8 * (r >> 2); const float rl = __builtin_amdgcn_rcpf(li_l[orow + 4 * hie] + li_l[32 + orow + 4 * hie]);
#pragma unroll
        for (int d0 = 0; d0 < 4; ++d0) *(LAS bf16_t*)(st + (orow + 4 * hie) * 272 + (d0 * 32 + r32e) * 2) = (bf16_t)f2bf(o[d0][r] * rl); }
    asm volatile("s_waitcnt lgkmcnt(0)" ::: "memory");
    bf16_t* Ow = Ob + (size_t)(wid * 32) * 1024;
#pragma unroll
    for (int k = 0; k < 8; ++k) { const int p = lane2 + 64 * k, prow = p >> 4, pc = p & 15;
        const u32x4 v = *(const LAS u32x4*)(st + prow * 272 + pc * 16);
        *(u32x4*)(Ow + (size_t)prow * 1024 + pc * 8) = v; }
    asm volatile("s_waitcnt lgkmcnt(0)" ::: "memory");
}
}

__device__ __forceinline__ void attn_phase(const Frame& F, int l) {
    const int nitems = (l == 0) ? 512 + 64 : 512;
    const int vcu = (F.G % 8 == 0) ? (F.bid % 8) * (F.G / 8) + F.bid / 8 : F.bid;
    const bf16_t* Q = WSP(bf16_t, WS_Q); const bf16_t* KV = WSP(bf16_t, WS_KV); const bf16_t* KR = WSP(bf16_t, WS_KROPE); bf16_t* AO = WSP(bf16_t, WS_AO);
    const float* gkn = F.in[IN_KNNOPE] + l * 128; const float* gkr = F.in[IN_KNROPE] + l * 64; const float* gqn = F.in[IN_QNNOPE] + l * 128; const float* gqr = F.in[IN_QNROPE] + l * 64;
    float m1 = fmaxf(fabsf(gkn[F.lane]), fabsf(gkn[64 + F.lane])), m2 = fabsf(gkr[F.lane]);
    m1 = wave_max(m1); m2 = wave_max(m2);
    const float kbound = 1.02f * sqrtf(128.0f * m1 * m1 + 64.0f * m2 * m2);
    for (int item = vcu; item < nitems; item += F.G) {
        int b, h, row0, NT, tpos0;
        if (item < 512) { const int bh = item >> 3, qb = item & 7; b = bh >> 3; h = bh & 7; row0 = b * SEQ + qb * 256; NT = (SEQ + CTXL) / 64; tpos0 = qb * 256; }
        else { const int bh = item - 512; b = bh >> 3; h = bh & 7; row0 = TX + b * CTXL; NT = CTXL / 64; tpos0 = -1; }
        __syncthreads();
        att::attn_unit(Q + (size_t)row0 * 1536 + h * 192, gqn, gqr, kbound, tpos0, KV + h * 256, KR, AO + (size_t)row0 * 1024 + h * 128, TX + b * CTXL, b * SEQ, NT, (LAS char*)F.lds, F.tid);
    }
    __syncthreads();
}

namespace ret {
typedef short bf16x8 __attribute__((ext_vector_type(8)));
typedef float f32x4 __attribute__((ext_vector_type(4)));
constexpr int QS = 144, TS = 272;
constexpr int OFF_Q = 0, OFF_K = OFF_Q + 128 * QS, OFF_KT = OFF_K + 128 * QS, OFF_VT = OFF_KT + 64 * TS, OFF_A = OFF_VT + 32 * TS, OFF_ST = OFF_A + 128 * TS, RET_LDS = OFF_ST + 32 * QS;
static_assert(RET_LDS <= RING_BYTES, "retention LDS");
__device__ __forceinline__ bf16x8 ldsv(const LAS char* p) { return *(const LAS bf16x8*)p; }

__device__ __forceinline__ void ret_item(const Frame& F, int l, int b, int h, int dir, int dvq) {
    LAS char* lds = (LAS char*)F.lds;
    int tid = F.tid; asm volatile("" : "+v"(tid));
    const int w = __builtin_amdgcn_readfirstlane(tid >> 6), lane = tid & 63, lr = lane & 15, g = lane >> 4;
    const bf16_t* Z = WSP(bf16_t, WS_Z);
    const float lg2 = log2_gamma(F, l, dir, h);
    const float cd = __builtin_amdgcn_exp2f(128.0f * lg2);
    f32x4 S = {0.f, 0.f, 0.f, 0.f};
    const int qrow0 = tid >> 3, qc8 = tid & 7, vrow = tid >> 2, vc4 = tid & 3;
    v4u rq[2], rk[2], rv;
#define RET_ROW0(p) ((p) < 2 ? TX + b * CTXL + 128 * (dir ? 1 - (p) : (p)) : b * SEQ + 128 * (dir ? 17 - (p) : (p) - 2))
#define RET_LOAD(p) do { const int r0_ = RET_ROW0(p); \
        _Pragma("unroll") for (int k_ = 0; k_ < 2; ++k_) { const bf16_t* zr_ = Z + (size_t)(r0_ + qrow0 + 64 * k_) * ZLD + h * 64 + qc8 * 8; rq[k_] = *(const v4u*)(zr_ + ZC_RQ); rk[k_] = *(const v4u*)(zr_ + ZC_RK); } \
        rv = *(const v4u*)(Z + (size_t)(r0_ + vrow) * ZLD + ZC_RV + h * 128 + dvq * 32 + vc4 * 8); } while (0)
#define RET_STORE() do { \
        _Pragma("unroll") for (int k_ = 0; k_ < 2; ++k_) { const int row_ = qrow0 + 64 * k_; const int e_ = dir ? 127 - row_ : row_; const float kd_ = 0.125f * __builtin_amdgcn_exp2f((float)(127 - e_) * lg2); \
            *(LAS v4u*)(lds + OFF_Q + row_ * QS + qc8 * 16) = rq[k_]; \
            const unsigned kw_[4] = {rk[k_].x, rk[k_].y, rk[k_].z, rk[k_].w}; v4u ks_; unsigned* ksp_ = (unsigned*)&ks_; \
            _Pragma("unroll") for (int q_ = 0; q_ < 4; ++q_) { const float lo_ = bflo(kw_[q_]), hi_ = bfhi(kw_[q_]); ksp_[q_] = pk2(lo_ * 0.125f, hi_ * 0.125f); \
                *(LAS bf16_t*)(lds + OFF_KT + (qc8 * 8 + 2 * q_) * TS + row_ * 2) = (bf16_t)f2bf(lo_ * kd_); *(LAS bf16_t*)(lds + OFF_KT + (qc8 * 8 + 2 * q_ + 1) * TS + row_ * 2) = (bf16_t)f2bf(hi_ * kd_); } \
            *(LAS v4u*)(lds + OFF_K + row_ * QS + qc8 * 16) = ks_; } \
        { const unsigned vw_[4] = {rv.x, rv.y, rv.z, rv.w}; \
          _Pragma("unroll") for (int q_ = 0; q_ < 4; ++q_) { *(LAS bf16_t*)(lds + OFF_VT + (vc4 * 8 + 2 * q_) * TS + vrow * 2) = (bf16_t)(vw_[q_] & 0xffffu); *(LAS bf16_t*)(lds + OFF_VT + (vc4 * 8 + 2 * q_ + 1) * TS + vrow * 2) = (bf16_t)(vw_[q_] >> 16); } } } while (0)
    __syncthreads();
    RET_LOAD(0); RET_STORE();
    { unsigned z0; asm volatile("v_mov_b32 %0, 0" : "=v"(z0));
      if (tid < 288) *(LAS unsigned*)(lds + OFF_ST + tid * 16) = z0, *(LAS unsigned*)(lds + OFF_ST + tid * 16 + 4) = z0, *(LAS unsigned*)(lds + OFF_ST + tid * 16 + 8) = z0, *(LAS unsigned*)(lds + OFF_ST + tid * 16 + 12) = z0; }
    __syncthreads();
    for (int p = 0; p < 18; ++p) {
        if (p + 1 < 18) RET_LOAD(p + 1);
        const bool want_out = (p >= 2) || (l == 0);
        if (want_out) {
            bf16x8 qf[2];
#pragma unroll
            for (int ks = 0; ks < 2; ++ks) qf[ks] = ldsv(lds + OFF_Q + (16 * w + lr) * QS + ks * 64 + g * 16);
            const int i = 16 * w + lr, ei = dir ? 127 - i : i;
#pragma unroll
            for (int ct = 0; ct < 8; ++ct) {
                f32x4 a = {0.f, 0.f, 0.f, 0.f};
#pragma unroll
                for (int ks = 0; ks < 2; ++ks) a = __builtin_amdgcn_mfma_f32_16x16x32_bf16(ldsv(lds + OFF_K + (16 * ct + lr) * QS + ks * 64 + g * 16), qf[ks], a, 0, 0, 0);
                float m[4];
#pragma unroll
                for (int r = 0; r < 4; ++r) { const int j = 16 * ct + 4 * g + r, ej = dir ? 127 - j : j; m[r] = ei >= ej ? a[r] * __builtin_amdgcn_exp2f((float)(ei - ej) * lg2) : 0.f; }
                v2u wv; wv.x = pk2(m[0], m[1]); wv.y = pk2(m[2], m[3]);
                *(LAS v2u*)(lds + OFF_A + i * TS + (16 * ct + 4 * g) * 2) = wv;
            }
            f32x4 oc[2];
#pragma unroll
            for (int nt = 0; nt < 2; ++nt) { oc[nt] = (f32x4){0.f, 0.f, 0.f, 0.f};
#pragma unroll
                for (int ks = 0; ks < 2; ++ks) oc[nt] = __builtin_amdgcn_mfma_f32_16x16x32_bf16(qf[ks], ldsv(lds + OFF_ST + (16 * nt + lr) * QS + ks * 64 + g * 16), oc[nt], 0, 0, 0); }
#pragma unroll
            for (int r = 0; r < 4; ++r) { const int i2 = 16 * w + 4 * g + r, e2 = dir ? 127 - i2 : i2; const float qd = __builtin_amdgcn_exp2f((float)(e2 + 1) * lg2); oc[0][r] *= qd; oc[1][r] *= qd; }
            LDS_WAIT(); asm volatile("" ::: "memory");
#pragma unroll
            for (int ks = 0; ks < 4; ++ks) { const bf16x8 af = ldsv(lds + OFF_A + (16 * w + lr) * TS + ks * 64 + g * 16);
#pragma unroll
                for (int nt = 0; nt < 2; ++nt) oc[nt] = __builtin_amdgcn_mfma_f32_16x16x32_bf16(af, ldsv(lds + OFF_VT + (16 * nt + lr) * TS + ks * 64 + g * 16), oc[nt], 0, 0, 0); }
            float* ro = WSP(float, WS_RO) + (size_t)dir * TT * 512 + (size_t)(RET_ROW0(p) + 16 * w + 4 * g) * 512 + h * 128 + dvq * 32 + lr;
#pragma unroll
            for (int r = 0; r < 4; ++r) { ro[r * 512] = oc[0][r]; ro[r * 512 + 16] = oc[1][r]; }
        }
        S = S * cd;
#pragma unroll
        for (int ks = 0; ks < 4; ++ks) S = __builtin_amdgcn_mfma_f32_16x16x32_bf16(ldsv(lds + OFF_KT + (16 * (w >> 1) + lr) * TS + ks * 64 + g * 16), ldsv(lds + OFF_VT + (16 * (w & 1) + lr) * TS + ks * 64 + g * 16), S, 0, 0, 0);
        __syncthreads();
        { v2u sv; sv.x = pk2(S[0], S[1]); sv.y = pk2(S[2], S[3]); *(LAS v2u*)(lds + OFF_ST + (16 * (w & 1) + lr) * QS + (16 * (w >> 1) + 4 * g) * 2) = sv; }
        if (p + 1 < 18) RET_STORE();
        __syncthreads();
    }
#undef RET_ROW0
#undef RET_LOAD
#undef RET_STORE
}
}

__device__ __forceinline__ void ret_phase(const Frame& F, int l) {
    for (int item = F.bid; item < 256; item += F.G) { const int dvq = item & 3, dir = (item >> 2) & 1, h = (item >> 3) & 3, b = item >> 5; ret::ret_item(F, l, b, h, dir, dvq); }
    __syncthreads();
}

namespace hy {
#define HY_LDS LAS
#define HY_FN __device__ __forceinline__
#define HY_CPX_VEC 1
#ifdef HY_CPX_VEC
typedef float cpx __attribute__((ext_vector_type(2)));
#else
struct cpx { float x, y; };
#endif
HY_FN cpx cmul(cpx a, cpx b) { cpx r; r.x = a.x * b.x - a.y * b.y; r.y = a.x * b.y + a.y * b.x; return r; }
HY_FN cpx cadd(cpx a, cpx b) { cpx r; r.x = a.x + b.x; r.y = a.y + b.y; return r; }
HY_FN cpx csub(cpx a, cpx b) { cpx r; r.x = a.x - b.x; r.y = a.y - b.y; return r; }
HY_FN cpx cmuli_neg(cpx a) { cpx r; r.x = a.y; r.y = -a.x; return r; }
HY_FN void dft8(cpx (&v)[8]) {
    const float R = 0.70710678118654752f;
    cpx a0 = cadd(v[0], v[4]), a1 = cadd(v[1], v[5]), a2 = cadd(v[2], v[6]), a3 = cadd(v[3], v[7]);
    cpx b0 = csub(v[0], v[4]), b1 = csub(v[1], v[5]), b2 = csub(v[2], v[6]), b3 = csub(v[3], v[7]);
    { cpx t; t.x = (b1.x + b1.y) * R; t.y = (b1.y - b1.x) * R; b1 = t; }
    b2 = cmuli_neg(b2);
    { cpx t; t.x = (b3.y - b3.x) * R; t.y = -(b3.x + b3.y) * R; b3 = t; }
    { cpx s0 = cadd(a0, a2), s1 = csub(a0, a2), s2 = cadd(a1, a3), s3 = cmuli_neg(csub(a1, a3));
      v[0] = cadd(s0, s2); v[2] = cadd(s1, s3); v[4] = csub(s0, s2); v[6] = csub(s1, s3); }
    { cpx s0 = cadd(b0, b2), s1 = csub(b0, b2), s2 = cadd(b1, b3), s3 = cmuli_neg(csub(b1, b3));
      v[1] = cadd(s0, s2); v[3] = cadd(s1, s3); v[5] = csub(s0, s2); v[7] = csub(s1, s3); }
}
HY_FN cpx hlook(const HY_LDS cpx* Hh, int f) { if (f <= 2048) return Hh[f]; cpx h = Hh[4096 - f]; h.y = -h.y; return h; }
HY_FN int hpad(int i) { return i + (i >> 3); }
template <bool MULH> HY_FN void fft_pass_read(const HY_LDS cpx* X, const HY_LDS cpx* TW, const HY_LDS cpx* Hh, int j, int Ns, cpx (&v)[8]) {
#pragma unroll
    for (int t = 0; t < 8; ++t) { v[t] = X[hpad(j + 512 * t)]; if (MULH) { cpx r = cmul(v[t], hlook(Hh, j + 512 * t)); r.y = -r.y; v[t] = r; } }
    if (Ns > 1) {
        const int k = j & (Ns - 1);
        const cpx w1 = TW[k * (512 / Ns)];
        const cpx w2 = cmul(w1, w1), w3 = cmul(w2, w1), w4 = cmul(w2, w2), w5 = cmul(w4, w1), w6 = cmul(w3, w3), w7 = cmul(w4, w3);
        v[1] = cmul(v[1], w1); v[2] = cmul(v[2], w2); v[3] = cmul(v[3], w3); v[4] = cmul(v[4], w4); v[5] = cmul(v[5], w5); v[6] = cmul(v[6], w6); v[7] = cmul(v[7], w7);
    }
    dft8(v);
}
HY_FN void fft_pass_write(HY_LDS cpx* X, int j, int Ns, const cpx (&v)[8]) {
    const int k = j & (Ns - 1), j0 = ((j - k) << 3) + k;
#pragma unroll
    for (int u = 0; u < 8; ++u) X[hpad(j0 + u * Ns)] = v[u];
}

#undef HY_LDS
#undef HY_FN
constexpr int XBYTES = 4608 * 8;
constexpr int OFF_XA = 0, OFF_XB = XBYTES, OFF_H0 = 2 * XBYTES, OFF_H1 = OFF_H0 + 16400, OFF_TW = OFF_H1 + 16400, HY_LDS_BYTES = OFF_TW + 4096;
static_assert(HY_LDS_BYTES <= RING_BYTES, "hyena LDS");
template <bool MULH> __device__ __forceinline__ void fft4096(LAS cpx* A, LAS cpx* B, const LAS cpx* TW, const LAS cpx* Hh, int j) {
    cpx v[8];
    fft_pass_read<MULH>(A, TW, Hh, j, 1, v); fft_pass_write(B, j, 1, v); __syncthreads();
    fft_pass_read<false>(B, TW, Hh, j, 8, v); fft_pass_write(A, j, 8, v); __syncthreads();
    fft_pass_read<false>(A, TW, Hh, j, 64, v); fft_pass_write(B, j, 64, v); __syncthreads();
    fft_pass_read<false>(B, TW, Hh, j, 512, v); fft_pass_write(A, j, 512, v); __syncthreads();
}
__device__ __forceinline__ void sconv4(const bf16_t* rp, int t0, float w0, float w1, float w2, float bias, float (&o)[4]) {
    const v2u w = *(const v2u*)(rp + t0);
    const float u0 = bflo(w.x), u1 = bfhi(w.x), u2 = bflo(w.y), u3 = bfhi(w.y);
    const float um = t0 > 0 ? bf1(rp[t0 - 1]) : 0.f, up = t0 + 4 < SEQ ? bf1(rp[t0 + 4]) : 0.f;
    o[0] = w0 * um + w1 * u0 + w2 * u1 + bias; o[1] = w0 * u0 + w1 * u1 + w2 * u2 + bias; o[2] = w0 * u1 + w1 * u2 + w2 * u3 + bias; o[3] = w0 * u2 + w1 * u3 + w2 * up + bias;
}
__device__ __forceinline__ void hy_item(const Frame& F, int l, int c) {
    LAS char* lds = (LAS char*)F.lds;
    int tid = F.tid; asm volatile("" : "+v"(tid));
    LAS cpx* XA = (LAS cpx*)(lds + OFF_XA); LAS cpx* XB = (LAS cpx*)(lds + OFF_XB); LAS cpx* H0 = (LAS cpx*)(lds + OFF_H0); LAS cpx* H1 = (LAS cpx*)(lds + OFF_H1); LAS cpx* TW = (LAS cpx*)(lds + OFF_TW);
    const bf16_t* ZT = WSP(bf16_t, WS_ZT);
    const float* cw = F.in[IN_HCW] + (size_t)l * 3 * 1536; const float* cb = F.in[IN_HCB] + (size_t)l * 1536; const float* skip = F.in[IN_HSKIP] + (size_t)l * 2 * 512;
    __syncthreads();
    { float sn, cs; sincosf(6.2831853071795864f * (float)tid * (1.0f / 4096.0f), &sn, &cs); cpx t; t.x = cs; t.y = -sn; TW[tid] = t; }
    {
        const float* t0p = WSP(float, WS_TAPS) + (((size_t)l * 2 + 0) * 512 + c) * 4096 + 8 * tid; const float* t1p = t0p + (size_t)512 * 4096;
        const f32x4 a0 = *(const f32x4*)t0p, a1 = *((const f32x4*)t0p + 1), b0 = *(const f32x4*)t1p, b1 = *((const f32x4*)t1p + 1);
#pragma unroll
        for (int i = 0; i < 4; ++i) { cpx z; z.x = a0[i]; z.y = b0[i]; XA[9 * tid + i] = z; z.x = a1[i]; z.y = b1[i]; XA[9 * tid + 4 + i] = z; }
    }
    __syncthreads();
    fft4096<false>(XA, XB, TW, H0, tid);
    { const float sk0 = skip[c], sk1 = skip[512 + c], sc = 1.0f / 4096.0f;
      for (int f = tid; f <= 2048; f += NTHR) { const cpx zf = XA[hpad(f)], zn = XA[hpad((4096 - f) & 4095)]; cpx h;
          h.x = (0.5f * (zf.x + zn.x) + sk0) * sc; h.y = 0.5f * (zf.y - zn.y) * sc; H0[f] = h;
          h.x = (0.5f * (zf.y + zn.y) + sk1) * sc; h.y = -0.5f * (zf.x - zn.x) * sc; H1[f] = h; } }
    const int t0 = 4 * tid, p0 = t0 + (t0 >> 3), p1 = p0 + 2304;
    const float wx1[4] = {cw[c], cw[1536 + c], cw[3072 + c], cb[c]}, wx2[4] = {cw[512 + c], cw[1536 + 512 + c], cw[3072 + 512 + c], cb[512 + c]}, wv[4] = {cw[1024 + c], cw[1536 + 1024 + c], cw[3072 + 1024 + c], cb[1024 + c]};
    for (int q = 0; q < 4; ++q) {
        __syncthreads();
        float va[4], vb[4];
        sconv4(ZT + (size_t)(1024 + c) * TT + (2 * q) * SEQ, t0, wv[0], wv[1], wv[2], wv[3], va);
        sconv4(ZT + (size_t)(1024 + c) * TT + (2 * q + 1) * SEQ, t0, wv[0], wv[1], wv[2], wv[3], vb);
#pragma unroll
        for (int i = 0; i < 4; ++i) { cpx z; z.x = va[i]; z.y = vb[i]; XA[p0 + i] = z; z.x = 0.f; z.y = 0.f; XA[p1 + i] = z; }
        __syncthreads();
        fft4096<false>(XA, XB, TW, H0, tid); fft4096<true>(XA, XB, TW, H0, tid);
        {
            float ga[4], gb[4];
            sconv4(ZT + (size_t)c * TT + (2 * q) * SEQ, t0, wx1[0], wx1[1], wx1[2], wx1[3], ga);
            sconv4(ZT + (size_t)c * TT + (2 * q + 1) * SEQ, t0, wx1[0], wx1[1], wx1[2], wx1[3], gb);
#pragma unroll
            for (int i = 0; i < 4; ++i) { const cpx y = XA[p0 + i]; cpx z; z.x = ga[i] * y.x; z.y = gb[i] * (-y.y); XA[p0 + i] = z; z.x = 0.f; z.y = 0.f; XA[p1 + i] = z; }
        }
        __syncthreads();
        fft4096<false>(XA, XB, TW, H1, tid); fft4096<true>(XA, XB, TW, H1, tid);
        {   float ga[4], gb[4];
            sconv4(ZT + (size_t)(512 + c) * TT + (2 * q) * SEQ, t0, wx2[0], wx2[1], wx2[2], wx2[3], ga);
            sconv4(ZT + (size_t)(512 + c) * TT + (2 * q + 1) * SEQ, t0, wx2[0], wx2[1], wx2[2], wx2[3], gb);
            f32x4 oa, ob;
#pragma unroll
            for (int i = 0; i < 4; ++i) { const cpx y = XA[p0 + i]; oa[i] = ga[i] * y.x; ob[i] = gb[i] * (-y.y); }
            float* hp = WSP(float, WS_HY) + (size_t)c * TT + (2 * q) * SEQ + t0;
            *(f32x4*)hp = oa; *(f32x4*)(hp + SEQ) = ob;
        }
    }
    __syncthreads();
}
}

__device__ __forceinline__ void hyena_phase(const Frame& F, int l) {
    for (int c = F.bid; c < 512; c += F.G) hy::hy_item(F, l, c);
    __syncthreads();
}

#ifndef WGM_DEFAULT
#define WGM_DEFAULT 4
#endif
#ifndef WGM_GU
#define WGM_GU 4
#endif
#define PG8_ALIGN true
#define PG8_SP2 true
__device__ __forceinline__ bool rebase(Frame& F, const Args& args) {
    size_t zz = 0; asm volatile("s_mov_b64 %0, 0" : "=s"(zz)); F.in = args.in + zz; F.ws = args.ws + zz; F.out = args.out + zz;
    int wv = F.wave0; asm volatile("" : "+s"(wv));
    int ln; asm volatile("v_mbcnt_lo_u32_b32 %0, -1, 0\n\tv_mbcnt_hi_u32_b32 %0, -1, %0" : "=v"(ln)); int t = wv * 64 + ln; int g = gridDim.x, b = blockIdx.x; asm volatile("" : "+s"(g), "+s"(b));
    F.tid = t; F.lane = t & 63; F.wave = __builtin_amdgcn_readfirstlane(t >> 6); F.G = g; F.bid = b; F.gw = b * NWAVES + F.wave; F.NGW = g * NWAVES;
    return true;
}
template <class Epi>
__device__ __forceinline__ void run_gemm(const Frame& F, const bf16_t* A, const bf16_t* Bt, int M, int N, int K, const Epi& E, int wgm = WGM_DEFAULT) {
    pg8::Gemm g{A, Bt, M, N, K, K}; pg8::StaticOrder S; S.init(M, N, F.G, F.bid, wgm);
    pg8::gemm_phase<Epi, pg8::StaticOrder, PG8_ALIGN, PG8_SP2>(F.lds, g, S, E, F.tid);
}

__device__ __forceinline__ void run_down(const Frame& F, const bf16_t* Gbuf, const bf16_t* Wd, const float* resx, float* outx, const float* gate) {
    { pg8::EpiResid E{resx, resx, outx, outx, gate, 0.5f}; run_gemm(F, Gbuf, Wd, TX, DM, FF, E); }
    { pg8::Gemm g{Gbuf + (size_t)TX * FF, Wd, TC, DM, FF / 4, FF}; pg8::SplitKOrder S{F.G, F.bid, 4, FF / 4}; pg8::EpiPartial E{WSP(float, WS_PART), (FF / 4) * 2};
      pg8::gemm_phase<pg8::EpiPartial, pg8::SplitKOrder, PG8_ALIGN, PG8_SP2>(F.lds, g, S, E, F.tid); }
}

__global__ void __launch_bounds__(NTHR, 2) fwd_kernel(Args args) {
    extern __shared__ __attribute__((aligned(16))) unsigned char lds_raw[];
    Frame F;
    F.lds = (LAS unsigned char*)lds_raw;
    F.tid = threadIdx.x; F.lane = F.tid & 63; F.wave = __builtin_amdgcn_readfirstlane(F.tid >> 6); F.wave0 = F.wave;
    F.G = gridDim.x; F.bid = blockIdx.x; F.gw = blockIdx.x * NWAVES + F.wave; F.NGW = F.G * NWAVES;
    F.in = args.in; F.ws = args.ws; F.out = args.out;
    volatile LAS unsigned* MISC = (volatile LAS unsigned*)(F.lds + MISC_OFF);
    for (int u = F.tid; u < (LDS_BYTES - LDSCTL_OFF) / 4; u += NTHR) ((LAS unsigned*)(F.lds + LDSCTL_OFF))[u] = 0u;
    __syncthreads();
    const int lo = args.ph_lo, hi = args.ph_hi;
    const bool multi = (hi - lo) > 1; const int bsel = args.bar_sel;
    XcdBarrier bar; bar.bar = (unsigned*)(F.ws + WS_CTL) + CW_BAR + args.bar_sel * XCD_BAR_WORDS; bar.x = 0; bar.st = nullptr;
    if (multi) bar = xcd_barrier_post((unsigned*)(F.ws + WS_CTL) + CW_BAR + args.bar_sel * XCD_BAR_WORDS, MISC + 8, F.tid);
#ifdef STAMPS
#define STAMP(k) (((F.bid == 0 && F.tid == 0) ? (void)(((unsigned long long*)(F.ws + WS_END))[(k)] = __builtin_amdgcn_s_memrealtime()) : (void)0), true)
#else
#define STAMP(k) true
#endif
#define IN(k) (lo <= (k) && (k) < hi && rebase(F, args) && STAMP(k))
#define SEAM(k) do { if (lo <= (k) && (k) + 1 < hi && rebase(F, args)) { XcdBarrier b_ = bar; b_.bar = (unsigned*)(F.ws + WS_CTL) + CW_BAR + bsel * XCD_BAR_WORDS; xcd_barrier(b_, F.tid); } } while (0)

    if (IN(0)) { p0_modpart(F); rebase(F, args); (void)STAMP(48); p0_hyh2(F); rebase(F, args); (void)STAMP(49); p0_weights(F); } SEAM(0);

    for (int l = 0; l < 2; ++l) {
        const int pb = 2 + l * NPH_L;
#define wl (F.ws + WS_W + (size_t)l * LW)
#define modl (WSP(float, WS_MOD) + (size_t)l * 9 * NMODC)
#define xres WSP(float, WS_XRES)
#define xresc (WSP(float, WS_XRES) + (size_t)TX * DM)
#define srcx (l == 0 ? F.in[IN_X] : (const float*)xres)
#define srcc (l == 0 ? F.in[IN_CTX] : (const float*)xresc)
        const int Mmix = (l == 0) ? TT : TX;

        if (IN(pb + 0)) { norm_phase(F, srcx, srcc, TT, modl, 0, 1, WSP(bf16_t, WS_HMOD), l == 0 ? nullptr : WSP(float, WS_PART), WSP(float, WS_MOD) + 8 * NMODC + 8 * DM, xresc); if (l == 0) p1_taps(F); }
        SEAM(pb + 0);
        if (IN(pb + 1)) { { pg8::EpiSwiGLU E{WSP(bf16_t, WS_G), FF}; run_gemm(F, WSP(bf16_t, WS_HMOD), (const bf16_t*)(wl + LW_GU1), TT, 2 * FF, DM, E, WGM_GU); } }
        SEAM(pb + 1);
        if (IN(pb + 2)) run_down(F, WSP(bf16_t, WS_G), (const bf16_t*)(wl + LW_D1), srcx, xres, modl + 2 * DM);
        SEAM(pb + 2);
        if (IN(pb + 3)) norm_phase(F, xres, srcc, TT, modl, 3, 4, WSP(bf16_t, WS_HMOD), WSP(float, WS_PART), modl + 8 * NMODC + 2 * DM, xresc);
        SEAM(pb + 3);
        if (IN(pb + 4)) {
            { pg8::EpiBf16 E{WSP(bf16_t, WS_Z), ZLD}; run_gemm(F, WSP(bf16_t, WS_HMOD), (const bf16_t*)(wl + LW_WINM), TT, ZLD, DM, E); }
            { pg8::EpiBf16 E{WSP(bf16_t, WS_ZT), TT}; run_gemm(F, (const bf16_t*)(wl + LW_WINH), WSP(bf16_t, WS_HMOD), 1536, TT, DM, E); }
        }
        SEAM(pb + 4);
        if (IN(pb + 5)) postproj_phase(F, l);
        SEAM(pb + 5);
        if (IN(pb + 6)) {
            { pg8::EpiBf16 E{WSP(bf16_t, WS_KV), 2048}; run_gemm(F, WSP(bf16_t, WS_KVN), (const bf16_t*)(wl + LW_WUKV), TT, 2048, 256, E); }
            { pg8::EpiBf16 E{WSP(bf16_t, WS_Q), 1536}; run_gemm(F, WSP(bf16_t, WS_QN), (const bf16_t*)(wl + LW_WUQ), Mmix, 1536, 512, E); }
        }
        SEAM(pb + 6);
        if (IN(pb + 7)) headnorm_phase(F, l);
        SEAM(pb + 7);
        if (IN(pb + 8)) { const int mm = args.pad; if (mm & 1) attn_phase(F, l); rebase(F, args); (void)STAMP(32 + 4 * l); if (mm & 2) ret_phase(F, l); rebase(F, args); (void)STAMP(33 + 4 * l); if (mm & 4) hyena_phase(F, l); rebase(F, args); (void)STAMP(34 + 4 * l); if (mm & 8) hyena_ctx(F, l); }
        SEAM(pb + 8);
        if (IN(pb + 9)) merge_phase(F, l);
        SEAM(pb + 9);
        if (IN(pb + 10)) {
            { pg8::EpiResid E{xres, xresc, xres, xresc, modl + 5 * DM, 1.0f}; run_gemm(F, WSP(bf16_t, WS_HMOD), (const bf16_t*)(wl + LW_WOUT), TX, DM, DM, E); }
            if (l == 0) { pg8::Gemm g{WSP(bf16_t, WS_HMOD) + (size_t)TX * DM, (const bf16_t*)(wl + LW_WOUT), TC, DM, DM / 4, DM}; pg8::SplitKOrder S{F.G, F.bid, 4, DM / 4}; pg8::EpiPartial E{WSP(float, WS_PART), (DM / 4) * 2};
                pg8::gemm_phase<pg8::EpiPartial, pg8::SplitKOrder, PG8_ALIGN, PG8_SP2>(F.lds, g, S, E, F.tid); }
        }
        SEAM(pb + 10);
        if (IN(pb + 11)) norm_phase(F, xres, xresc, Mmix, modl, 6, 7, WSP(bf16_t, WS_HMOD), l == 0 ? WSP(float, WS_PART) : nullptr, modl + 8 * NMODC + 5 * DM, xresc, 1.0f);
        SEAM(pb + 11);
        if (IN(pb + 12)) { { pg8::EpiSwiGLU E{WSP(bf16_t, WS_G), FF}; run_gemm(F, WSP(bf16_t, WS_HMOD), (const bf16_t*)(wl + LW_GU2), Mmix, 2 * FF, DM, E, WGM_GU); } }
        SEAM(pb + 12);
        if (IN(pb + 13)) { if (l == 0) run_down(F, WSP(bf16_t, WS_G), (const bf16_t*)(wl + LW_D2), xres, xres, modl + 8 * DM);
            else { pg8::EpiResid E{xres, xresc, F.out, xresc, modl + 8 * DM, 0.5f}; run_gemm(F, WSP(bf16_t, WS_G), (const bf16_t*)(wl + LW_D2), TX, DM, FF, E); } }
        if (l == 0) SEAM(pb + 13);
    }
    if (hi == NPH) { rebase(F, args); (void)STAMP(NPH); }
#undef IN
#undef SEAM
#undef wl
#undef modl
#undef xres
#undef xresc
#undef srcx
#undef srcc
}

#ifdef STAMPS
__global__ void spin_kernel(const unsigned long long* ts, int k0, int k1, int factor) {
    if (threadIdx.x == 0) { const unsigned long long d = (ts[k1] - ts[k0]) * (unsigned long long)factor, t0 = __builtin_amdgcn_s_memrealtime();
        while (__builtin_amdgcn_s_memrealtime() - t0 < d) __builtin_amdgcn_s_sleep(16); }
}
#endif
#ifndef MK_ONE_LAUNCH
#define MK_ONE_LAUNCH 1
#endif
extern "C" void kernel_launch(void* const* d_in, const int* in_sizes, int n_in, void* d_out, int out_size, void* d_ws, size_t ws_size, hipStream_t stream) {
    static int grid = 0;
    if (grid == 0) {
        if (n_in != N_IN || out_size != TX * DM || ws_size < WS_END + 4096) { fprintf(stderr, "kernel_launch: unexpected shapes (n_in %d, out %d, ws %zu < %zu)\n", n_in, out_size, ws_size, (size_t)WS_END); grid = -1; return; }
        int dev = 0, cus = 0, per_cu = 0;
        if (hipGetDevice(&dev) != hipSuccess || hipDeviceGetAttribute(&cus, hipDeviceAttributeMultiprocessorCount, dev) != hipSuccess) { grid = -1; return; }
        if (hipFuncSetAttribute((const void*)fwd_kernel, hipFuncAttributeMaxDynamicSharedMemorySize, LDS_BYTES) != hipSuccess) { fprintf(stderr, "kernel_launch: hipFuncSetAttribute failed\n"); grid = -1; return; }
        if (hipOccupancyMaxActiveBlocksPerMultiprocessor(&per_cu, (const void*)fwd_kernel, NTHR, LDS_BYTES) != hipSuccess || per_cu < 1) { fprintf(stderr, "kernel_launch: occupancy query reports %d blocks per CU\n", per_cu); }
        (void)hipGetLastError();
        grid = cus;
    }
    if (grid < 0) return;
    (void)hipMemsetAsync((char*)d_ws + WS_CTL, 0, CTL_BYTES + (size_t)2 * 9 * NMODC * 4, stream);
    Args a{};
    for (int i = 0; i < N_IN; ++i) a.in[i] = (const float*)d_in[i];
    a.out = (float*)d_out; a.ws = (unsigned char*)d_ws; a.pad = 15;
#if MK_ONE_LAUNCH
    a.ph_lo = 0; a.ph_hi = NPH;
    hipLaunchKernelGGL(fwd_kernel, dim3(grid), dim3(NTHR), LDS_BYTES, stream, a);
#ifdef STAMPS
    hipLaunchKernelGGL(spin_kernel, dim3(1), dim3(64), 0, stream, (const unsigned long long*)((const char*)d_ws + WS_END), PROBE_K0, PROBE_K1, PROBE_F);
#endif
#ifdef PROBE_LO
    a.ph_lo = PROBE_LO; a.ph_hi = PROBE_HI; a.bar_sel = 1;
#ifdef PROBE_MASK
    a.pad = PROBE_MASK;
#endif
    hipLaunchKernelGGL(fwd_kernel, dim3(grid), dim3(NTHR), LDS_BYTES, stream, a);
#endif
#else
    for (int ph = 0; ph < NPH; ++ph) { a.ph_lo = ph; a.ph_hi = ph + 1; hipLaunchKernelGGL(fwd_kernel, dim3(grid), dim3(NTHR), LDS_BYTES, stream, a); }
#endif
}
```

```cpp
#include <hip/hip_runtime.h>
#include <cstdio>
#include <cstdint>
#include <cmath>

namespace pg8 {
#define PG8_LAS __attribute__((address_space(3)))
typedef unsigned short bf16_t;
typedef short bf16x8 __attribute__((ext_vector_type(8)));
typedef float f32x4 __attribute__((ext_vector_type(4)));
typedef unsigned u32x4 __attribute__((ext_vector_type(4)));
constexpr int BM = 256, BK = 64, HALF = 128, HTB = HALF * BK * 2, STAGE_BYTES = 8 * HTB, NXCD = 8, WGM = 4;

__host__ __device__ __forceinline__ int lds_byte(int r, int c) { const int st = (r >> 4) * 2 + (c >> 5), rr = r & 15, cc = c & 31, ob = rr * 64 + cc * 2; return st * 1024 + (ob ^ (((ob >> 9) & 1) << 5)); }
__host__ __device__ __forceinline__ void stage_rc(int b, int& R, int& C) { const int st = b / 1024, sb = b % 1024, swz = sb ^ (((sb >> 9) & 1) << 5); R = (st >> 1) * 16 + swz / 64; C = (st & 1) * 32 + (swz % 64) / 2; }
__host__ __device__ __forceinline__ int perm32(int rho) { const int n = rho >> 4, i = rho & 15; return 8 * (i >> 2) + 4 * n + (i & 3); }

struct Unit { int pm, pn, koff; };
struct Gemm { const bf16_t* A; const bf16_t* Bt; int M, N, K, ld; };

struct StaticOrder {
    int nM, nN, nwg, G, c, wgm;
    __host__ __device__ void init(int M, int N, int G_, int c_, int wgm_ = WGM) { nM = M / BM; nN = N / BM; nwg = nM * nN; G = G_; c = c_; wgm = wgm_; }
    __host__ __device__ bool next(int i, Unit& u) const {
        const long L = (long)i * G + c; if (L >= nwg) return false;
        int wgid = (int)L; { const int q = nwg / NXCD, r = nwg % NXCD, xcd = wgid % NXCD, off = wgid / NXCD; wgid = (xcd < r ? xcd * (q + 1) : r * (q + 1) + (xcd - r) * q) + off; }
        const int nig = wgm * nN, gid = wgid / nig, fm = gid * wgm, gsz = (nM - fm) < wgm ? (nM - fm) : wgm;
        u.pm = fm + ((wgid % nig) % gsz); u.pn = (wgid % nig) / gsz; u.koff = 0; return true;
    }
    __device__ __forceinline__ void a_ready(const Unit&) const {}
    __device__ __forceinline__ void done(const Unit&) const {}
};

struct SplitKOrder {
    int G, c, KS, kc;
    __device__ __forceinline__ bool next(int i, Unit& u) const { const int L = i * G + c; if (L >= 64 * KS) return false; const int ks = L % KS, t = L / KS; u.pn = t & 7; u.pm = t >> 3; u.koff = ks * kc * 2; return true; }
    __device__ __forceinline__ void a_ready(const Unit&) const {}
    __device__ __forceinline__ void done(const Unit&) const {}
};
__device__ __forceinline__ unsigned cvt_pk_bf16(float lo, float hi) { unsigned r; asm volatile("v_cvt_pk_bf16_f32 %0, %1, %2" : "=v"(r) : "v"(lo), "v"(hi)); return r; }

__device__ __forceinline__ float silu_f(float x) { return x * __builtin_amdgcn_rcpf(1.0f + __builtin_amdgcn_exp2f(-1.44269504089f * x)); }

struct EpiBf16 {
    static constexpr bool PERM = true, AFTER_DRAIN = false;
    bf16_t* O; int ldc;
    __device__ __forceinline__ void operator()(const f32x4 (&acc)[2][2][4][2], const Unit& u, int wr, int wc, int fr, int fq) const {
        const int row0 = u.pm * BM + wr * 64 + fr, col0 = u.pn * BM + wc * 32 + 8 * fq;
#pragma unroll
        for (int ai = 0; ai < 2; ++ai)
#pragma unroll
            for (int m = 0; m < 4; ++m) { bf16_t* rowp = O + (size_t)(row0 + ai * HALF + m * 16) * ldc + col0;
#pragma unroll
                for (int bj = 0; bj < 2; ++bj) { const f32x4 v0 = acc[ai][bj][m][0], v1 = acc[ai][bj][m][1];
                    u32x4 w; w.x = cvt_pk_bf16(v0[0], v0[1]); w.y = cvt_pk_bf16(v0[2], v0[3]); w.z = cvt_pk_bf16(v1[0], v1[1]); w.w = cvt_pk_bf16(v1[2], v1[3]);
                    *(u32x4*)(rowp + bj * HALF) = w; } }
    }
};
struct EpiSwiGLU {
    static constexpr bool PERM = true, AFTER_DRAIN = false;
    bf16_t* O; int ldc;
    __device__ __forceinline__ void operator()(const f32x4 (&acc)[2][2][4][2], const Unit& u, int wr, int wc, int fr, int fq) const {
        const int row0 = u.pm * BM + wr * 64 + fr, col0 = u.pn * HALF + wc * 32 + 8 * fq;
#pragma unroll
        for (int ai = 0; ai < 2; ++ai)
#pragma unroll
            for (int m = 0; m < 4; ++m) { bf16_t* rowp = O + (size_t)(row0 + ai * HALF + m * 16) * ldc + col0;
                const f32x4 g0 = acc[ai][0][m][0], g1 = acc[ai][0][m][1], u0 = acc[ai][1][m][0], u1 = acc[ai][1][m][1];
                float r[8];
#pragma unroll
                for (int j = 0; j < 4; ++j) { r[j] = silu_f(g0[j]) * u0[j]; r[4 + j] = silu_f(g1[j]) * u1[j]; }
                u32x4 w; w.x = cvt_pk_bf16(r[0], r[1]); w.y = cvt_pk_bf16(r[2], r[3]); w.z = cvt_pk_bf16(r[4], r[5]); w.w = cvt_pk_bf16(r[6], r[7]);
                *(u32x4*)rowp = w; }
    }
};
struct EpiPartial {
    static constexpr bool PERM = false, AFTER_DRAIN = false;
    float* part; int kbytes;
    __device__ __forceinline__ void operator()(const f32x4 (&acc)[2][2][4][2], const Unit& u, int wr, int wc, int fr, int fq) const {
        const int rl0 = wr * 64 + fr, col0 = u.pn * BM + wc * 32 + 4 * fq, ks = u.koff / kbytes;
        float* op = part + ((size_t)ks * 2048 + (size_t)u.pm * BM) * 2048;
#pragma unroll
        for (int ai = 0; ai < 2; ++ai)
#pragma unroll
            for (int m = 0; m < 4; ++m) { float* o = op + (size_t)(rl0 + ai * HALF + m * 16) * 2048 + col0;
#pragma unroll
                for (int bj = 0; bj < 2; ++bj)
#pragma unroll
                    for (int n = 0; n < 2; ++n) *(f32x4*)(o + bj * HALF + n * 16) = acc[ai][bj][m][n]; }
    }
};
struct EpiResid {
    static constexpr bool PERM = false, AFTER_DRAIN = false;
    const float* resx; const float* resc; float* outx; float* outc; const float* gate; float coef;
    __device__ __forceinline__ void operator()(const f32x4 (&acc)[2][2][4][2], const Unit& u, int wr, int wc, int fr, int fq) const {
        const int rl0 = wr * 64 + fr, col0 = u.pn * BM + wc * 32 + 4 * fq;
        const bool isx = u.pm < 64;
        const float* rp = isx ? resx + (size_t)u.pm * BM * 2048 : resc + (size_t)(u.pm - 64) * BM * 2048;
        float* op = isx ? outx + (size_t)u.pm * BM * 2048 : outc + (size_t)(u.pm - 64) * BM * 2048;
        const float* gp = gate + (size_t)(isx ? (u.pm >> 3) : 8) * 18432 + col0;
#define PG8_ROFF(i) ((size_t)(rl0 + (((i) >> 2) & 1) * HALF + ((i) & 3) * 16) * 2048 + col0 + ((i) >> 4) * HALF + (((i) >> 3) & 1) * 16)
        f32x4 buf[12], gv[2], gvc;
        gv[0] = *(const f32x4*)gp;
#pragma unroll
        for (int i = 0; i < 12; ++i) buf[i] = *(const f32x4*)(rp + PG8_ROFF(i));
#pragma unroll
        for (int i = 0; i < 32; ++i) {
            asm volatile("" ::: "memory");
            if ((i & 7) == 0) { gvc = gv[(i >> 3) & 1] * coef; if (i + 8 < 32) gv[((i >> 3) + 1) & 1] = *(const f32x4*)(gp + ((i + 8) >> 4) * HALF + (((i + 8) >> 3) & 1) * 16); }
            *(f32x4*)(op + PG8_ROFF(i)) = buf[i % 12] + gvc * acc[(i >> 2) & 1][i >> 4][i & 3][(i >> 3) & 1];
            if (i + 12 < 32) buf[i % 12] = *(const f32x4*)(rp + PG8_ROFF(i + 12));
        }
#undef PG8_ROFF
    }
};

template <class Epi, class Sched, bool ALIGN_EPI = false, bool SP2 = false>
__device__ __forceinline__ void gemm_phase(PG8_LAS unsigned char* lds, const Gemm g, const Sched& S, const Epi& E, int tid) {
    asm volatile("" : "+v"(tid));
    const int  wid = __builtin_amdgcn_readfirstlane(tid >> 6), lane = tid & 63, wr = wid >> 2, wc = wid & 3, fr = lane & 15, fq = lane >> 4;
    const int K = g.ld, nt = g.K / BK;
    unsigned voffA[2], voffB[2];
#pragma unroll
    for (int i = 0; i < 2; ++i) { int R, C; stage_rc(tid * 16 + i * 8192, R, C); const int Rb = Epi::PERM ? ((R & ~31) + perm32(R & 31)) : R;
        voffA[i] = (unsigned)(R * K + C) * 2u; voffB[i] = (unsigned)(Rb * K + C) * 2u; }
    const size_t kstep = (size_t)(BK * 2);
    const size_t hstep = (size_t)HALF * K * 2;
    const size_t tstep = 2 * hstep;
    const unsigned ldsw = (unsigned)wid * 1024u;
    const int aoff = lds_byte(wr * 64 + fr, fq * 8), boff = lds_byte(wc * 32 + fr, fq * 8);
#define PG8_SA(b, h) (((b) * 2 + (h)) * HTB)
#define PG8_SB(b, h) ((4 + (b) * 2 + (h)) * HTB)
#define PG8_STAGE(bufoff, gbase, voff) do { _Pragma("unroll") for (int _i = 0; _i < 2; ++_i) \
        __builtin_amdgcn_global_load_lds((const unsigned*)((const char*)(gbase) + (voff)[_i]), (PG8_LAS unsigned*)(lds + (bufoff) + ldsw + _i * 8192), 16, 0, 0); } while (0)
#define PG8_LDA(dst, b, h) do { _Pragma("unroll") for (int m = 0; m < 4; ++m) _Pragma("unroll") for (int k = 0; k < 2; ++k) dst[m][k] = *(const PG8_LAS bf16x8*)(lds + PG8_SA(b, h) + aoff + m * 2048 + k * 1024); } while (0)
#define PG8_LDB(dst, b, h) do { _Pragma("unroll") for (int n = 0; n < 2; ++n) _Pragma("unroll") for (int k = 0; k < 2; ++k) dst[n][k] = *(const PG8_LAS bf16x8*)(lds + PG8_SB(b, h) + boff + n * 2048 + k * 1024); } while (0)
#define PG8_MMA(ai, bj, At, Bt) do { __builtin_amdgcn_s_setprio(1); _Pragma("unroll") for (int m = 0; m < 4; ++m) _Pragma("unroll") for (int n = 0; n < 2; ++n) _Pragma("unroll") for (int k = 0; k < 2; ++k) \
        acc[ai][bj][m][n] = __builtin_amdgcn_mfma_f32_16x16x32_bf16(Bt[n][k], At[m][k], acc[ai][bj][m][n], 0, 0, 0); __builtin_amdgcn_s_setprio(0); } while (0)
#define PG8_WAIT_V(n) asm volatile("s_waitcnt vmcnt(" #n ")" ::: "memory")
#define PG8_WAIT_L(n) asm volatile("s_waitcnt lgkmcnt(" #n ")" ::: "memory")
#define PG8_BAR __builtin_amdgcn_s_barrier()
#define PG8_SCHED __builtin_amdgcn_sched_barrier(0)
    Unit cur, nxt; int ui = 0;
    if (!S.next(0, cur)) return;
    f32x4 acc[2][2][4][2];
#pragma unroll
    for (int a = 0; a < 2; ++a)
#pragma unroll
        for (int b = 0; b < 2; ++b)
#pragma unroll
            for (int m = 0; m < 4; ++m)
#pragma unroll
                for (int n = 0; n < 2; ++n) acc[a][b][m][n] = (f32x4){0.f, 0.f, 0.f, 0.f};
    bf16x8 At[4][2], B0[2][2], B1[2][2];
    const char* cA = (const char*)g.A + (size_t)cur.pm * tstep + cur.koff; const char* cB = (const char*)g.Bt + (size_t)cur.pn * tstep + cur.koff;
    S.a_ready(cur);
    if constexpr (SP2) {
        PG8_STAGE(PG8_SB(0, 0), cB, voffB); PG8_STAGE(PG8_SB(0, 1), cB + hstep, voffB); PG8_STAGE(PG8_SA(0, 0), cA, voffA); PG8_STAGE(PG8_SA(0, 1), cA + hstep, voffA);
        if (wr == 1) PG8_BAR;
        PG8_WAIT_V(2); PG8_BAR;
        PG8_STAGE(PG8_SB(1, 0), cB + kstep, voffB); PG8_STAGE(PG8_SA(1, 0), cA + kstep, voffA); PG8_STAGE(PG8_SB(1, 1), cB + hstep + kstep, voffB);
        PG8_WAIT_V(6); PG8_BAR;
    } else {
        PG8_STAGE(PG8_SB(0, 0), cB, voffB); PG8_STAGE(PG8_SA(0, 0), cA, voffA); PG8_STAGE(PG8_SB(0, 1), cB + hstep, voffB); PG8_STAGE(PG8_SA(0, 1), cA + hstep, voffA);
        if (wr == 1) PG8_BAR;
        PG8_WAIT_V(4); PG8_BAR;
        PG8_STAGE(PG8_SB(1, 0), cB + kstep, voffB); PG8_STAGE(PG8_SA(1, 0), cA + kstep, voffA); PG8_STAGE(PG8_SB(1, 1), cB + hstep + kstep, voffB);
        PG8_WAIT_V(6); PG8_BAR;
    }
    for (;;) {
        const bool has_next = S.next(ui + 1, nxt);
        const char* nA = has_next ? (const char*)g.A + (size_t)nxt.pm * tstep + nxt.koff : cA; const char* nB = has_next ? (const char*)g.Bt + (size_t)nxt.pn * tstep + nxt.koff : cB;
        for (int t = 0; t < nt; t += 2) {
            const bool last = (t == nt - 2);
            const char* a1 = cA + (size_t)(t + 1) * kstep;
            const char* a2 = last ? nA : cA + (size_t)(t + 2) * kstep; const char* b2 = last ? nB : cB + (size_t)(t + 2) * kstep;
            const char* a3 = a2 + kstep; const char* b3 = b2 + kstep;
            if (last && has_next) S.a_ready(nxt);
            if constexpr (SP2) {
            PG8_LDB(B0, 0, 0); PG8_LDB(B1, 0, 1); PG8_SCHED; PG8_LDA(At, 0, 0); PG8_STAGE(PG8_SA(1, 1), a1 + hstep, voffA);
            PG8_WAIT_V(8); PG8_WAIT_L(0); PG8_BAR; PG8_MMA(0, 0, At, B0); PG8_MMA(0, 1, At, B1); PG8_BAR; PG8_SCHED;
            PG8_LDA(At, 0, 1); PG8_STAGE(PG8_SB(0, 0), b2, voffB); PG8_STAGE(PG8_SB(0, 1), b2 + hstep, voffB); PG8_STAGE(PG8_SA(0, 0), a2, voffA);
            PG8_WAIT_V(8); PG8_WAIT_L(0); PG8_BAR; PG8_MMA(1, 0, At, B0); PG8_MMA(1, 1, At, B1); PG8_BAR; PG8_SCHED;
            PG8_LDB(B0, 1, 0); PG8_LDB(B1, 1, 1); PG8_SCHED; PG8_LDA(At, 1, 0); PG8_STAGE(PG8_SA(0, 1), a2 + hstep, voffA);
            PG8_WAIT_V(8); PG8_WAIT_L(0); PG8_BAR; PG8_MMA(0, 0, At, B0); PG8_MMA(0, 1, At, B1); PG8_BAR; PG8_SCHED;
            PG8_LDA(At, 1, 1); PG8_STAGE(PG8_SB(1, 0), b3, voffB); PG8_STAGE(PG8_SB(1, 1), b3 + hstep, voffB); PG8_STAGE(PG8_SA(1, 0), a3, voffA);
            PG8_WAIT_V(8); PG8_WAIT_L(0); PG8_BAR; PG8_MMA(1, 0, At, B0); PG8_MMA(1, 1, At, B1); PG8_BAR; PG8_SCHED;
            } else {
            PG8_LDB(B0, 0, 0); PG8_SCHED; PG8_LDA(At, 0, 0); PG8_STAGE(PG8_SA(1, 1), a1 + hstep, voffA);
            PG8_WAIT_L(8); PG8_BAR; PG8_WAIT_L(0); PG8_MMA(0, 0, At, B0); PG8_BAR; PG8_SCHED;
            PG8_LDB(B1, 0, 1); PG8_STAGE(PG8_SB(0, 0), b2, voffB);
            PG8_BAR; PG8_WAIT_L(0); PG8_MMA(0, 1, At, B1); PG8_BAR;
            PG8_LDA(At, 0, 1); PG8_STAGE(PG8_SA(0, 0), a2, voffA);
            PG8_BAR; PG8_WAIT_L(0); PG8_MMA(1, 0, At, B0); PG8_BAR; PG8_SCHED;
            PG8_STAGE(PG8_SB(0, 1), b2 + hstep, voffB);
            PG8_WAIT_V(6); PG8_BAR; PG8_MMA(1, 1, At, B1); PG8_BAR;
            PG8_LDB(B0, 1, 0); PG8_SCHED; PG8_LDA(At, 1, 0); PG8_STAGE(PG8_SA(0, 1), a2 + hstep, voffA);
            PG8_WAIT_L(8); PG8_BAR; PG8_WAIT_L(0); PG8_MMA(0, 0, At, B0); PG8_BAR; PG8_SCHED;
            PG8_LDB(B1, 1, 1); PG8_STAGE(PG8_SB(1, 0), b3, voffB);
            PG8_BAR; PG8_WAIT_L(0); PG8_MMA(0, 1, At, B1); PG8_BAR;
            PG8_LDA(At, 1, 1); PG8_STAGE(PG8_SA(1, 0), a3, voffA);
            PG8_BAR; PG8_WAIT_L(0); PG8_MMA(1, 0, At, B0); PG8_BAR; PG8_SCHED;
            PG8_STAGE(PG8_SB(1, 1), b3 + hstep, voffB);
            PG8_WAIT_V(6); PG8_BAR; PG8_MMA(1, 1, At, B1); PG8_BAR;
            }
        }
        if constexpr (ALIGN_EPI) { if (wr == 0) PG8_BAR; }
        if constexpr (!Epi::AFTER_DRAIN) { E(acc, cur, wr, wc, fr, fq); S.done(cur); }
        if (!has_next) break;
#pragma unroll
        for (int a = 0; a < 2; ++a)
#pragma unroll
            for (int b = 0; b < 2; ++b)
#pragma unroll
                for (int m = 0; m < 4; ++m)
#pragma unroll
                    for (int n = 0; n < 2; ++n) acc[a][b][m][n] = (f32x4){0.f, 0.f, 0.f, 0.f};
        cur = nxt; cA = nA; cB = nB; ++ui;
        if constexpr (ALIGN_EPI) { if (wr == 1) PG8_BAR; }
    }
    PG8_WAIT_V(0);
    if constexpr (!ALIGN_EPI) { if (wr == 0) PG8_BAR; }
    PG8_BAR;
    if constexpr (Epi::AFTER_DRAIN) { E.fused(acc, cur, wr, wc, fr, fq, lds, wid, lane); S.done(cur); }
#undef PG8_SA
#undef PG8_SB
#undef PG8_STAGE
#undef PG8_LDA
#undef PG8_LDB
#undef PG8_MMA
#undef PG8_WAIT_V
#undef PG8_WAIT_L
#undef PG8_BAR
#undef PG8_SCHED
}
}

constexpr int NWAVES = 8, NTHR = 512;
constexpr int DM = 2048, NB = 8, SEQ = 2048, CTXL = 256, FF = 5632;
constexpr int TX = NB * SEQ, TC = NB * CTXL, TT = TX + TC;
constexpr int NMODC = 9 * DM;
constexpr float EPS = 1e-6f;
constexpr int ZC_KV = 0, ZC_RK = 256, ZC_RV = 512, ZC_KR = 1024, ZC_Q = 1280, ZC_RQ = 1792, ZC_RG = 2048, ZLD = 2560;
constexpr int NPH_L = 14, NPH = 2 + 2 * NPH_L;

enum { IN_X = 0, IN_C, IN_CTX, IN_CCTX, IN_ADAW, IN_ADAB, IN_F1G, IN_F1U, IN_F1D, IN_WIN, IN_QNORM, IN_WUQ, IN_KVNORM, IN_WUKV, IN_QNNOPE, IN_QNROPE, IN_KNNOPE, IN_KNROPE, IN_OUTNORM,
       IN_HCW, IN_HCB, IN_HW1, IN_HB1, IN_HW2, IN_HB2, IN_HW3, IN_HSKIP, IN_HONORM, IN_RDECAY, IN_RGNW, IN_RGNB, IN_WOUT, IN_F2G, IN_F2U, IN_F2D, N_IN };

constexpr size_t MiB = 1u << 20;
constexpr size_t SZ_WGU = (size_t)2 * FF * DM * 2, SZ_WD = (size_t)DM * FF * 2, SZ_WINM = (size_t)ZLD * DM * 2, SZ_WINH = (size_t)1536 * DM * 2,
                 SZ_WUQ = (size_t)1536 * 512 * 2, SZ_WUKV = (size_t)2048 * 256 * 2, SZ_WOUT = (size_t)DM * DM * 2;
constexpr size_t LW_GU1 = 0, LW_D1 = LW_GU1 + SZ_WGU, LW_GU2 = LW_D1 + SZ_WD, LW_D2 = LW_GU2 + SZ_WGU, LW_WINM = LW_D2 + SZ_WD, LW_WINH = LW_WINM + SZ_WINM,
                 LW_WUQ = LW_WINH + SZ_WINH, LW_WUKV = LW_WUQ + SZ_WUQ, LW_WOUT = LW_WUKV + SZ_WUKV, LW = LW_WOUT + SZ_WOUT;
constexpr size_t WS_CTL = 0, CTL_BYTES = 65536;
constexpr size_t WS_MOD = CTL_BYTES;
constexpr size_t WS_W = WS_MOD + (size_t)2 * 9 * NMODC * 4;
constexpr size_t WS_MODP = WS_W + 2 * LW;
constexpr size_t WS_H2 = WS_MODP;
constexpr size_t WS_H2C = WS_H2 + (size_t)2 * 2048 * 64 * 4;
constexpr size_t WS_TAPS = WS_H2C + (size_t)256 * 64 * 4;
constexpr size_t WS_TAPSC = WS_TAPS + (size_t)2 * 2 * 512 * 4096 * 4;
constexpr size_t WS_XRES = WS_TAPSC + (size_t)2 * 512 * 512 * 4;
constexpr size_t WS_HMOD = WS_XRES + (size_t)TT * DM * 4;
constexpr size_t WS_R = WS_HMOD + (size_t)TT * DM * 2;
constexpr size_t WS_G = WS_R;
constexpr size_t WS_Z = WS_R;
constexpr size_t WS_ZT = WS_Z + (size_t)TT * ZLD * 2;
constexpr size_t WS_KVN = WS_ZT + (size_t)1536 * TT * 2;
constexpr size_t WS_QN = WS_KVN + (size_t)TT * 256 * 2;
constexpr size_t WS_KROPE = WS_QN + (size_t)TT * 512 * 2;
constexpr size_t WS_KV = WS_KROPE + (size_t)TT * 64 * 2;
constexpr size_t WS_Q = WS_KV + (size_t)TT * 2048 * 2;
constexpr size_t WS_BQ = WS_Q + (size_t)TT * 1536 * 2;
constexpr size_t WS_AO = WS_BQ + (size_t)TT * 8 * 4;
constexpr size_t WS_HY = WS_AO + (size_t)TT * 1024 * 2;
constexpr size_t WS_RO = WS_HY + (size_t)512 * TT * 4;
constexpr size_t WS_PART = WS_RO + (size_t)2 * TT * 512 * 4;
constexpr size_t WS_END = WS_PART + (size_t)4 * TC * DM * 4;
static_assert(WS_G + (size_t)TT * FF * 2 <= WS_END, "G fits in the region");
static_assert(WS_END <= (size_t)1207959552, "workspace map must fit 4x the largest input");
static_assert(WS_W % 256 == 0 && LW % 256 == 0 && WS_MODP % 256 == 0 && WS_XRES % 256 == 0 && WS_R % 256 == 0 && WS_ZT % 256 == 0 && WS_KV % 256 == 0 && WS_Q % 256 == 0 && WS_HY % 256 == 0, "alignment");

constexpr int CW_BAR = 4096;

constexpr int RING_BYTES = 131072, LDSCTL_OFF = RING_BYTES, MISC_OFF = LDSCTL_OFF + 320, LDS_BYTES = 147456;

#define GAS __attribute__((address_space(1)))
#define LAS __attribute__((address_space(3)))
typedef unsigned short bf16_t;
typedef unsigned v4u __attribute__((ext_vector_type(4)));
typedef unsigned v2u __attribute__((ext_vector_type(2)));
typedef float f32x4 __attribute__((ext_vector_type(4)));
#define LDS_WAIT() asm volatile("s_waitcnt lgkmcnt(0)" ::: "memory")
#define VM_WAIT() asm volatile("s_waitcnt vmcnt(0)" ::: "memory")
__device__ __forceinline__ unsigned f2bf(float f) { unsigned u = __builtin_bit_cast(unsigned, f); return (u + 0x7fffu + ((u >> 16) & 1u)) >> 16; }
__device__ __forceinline__ unsigned pk2(float lo, float hi) { return f2bf(lo) | (f2bf(hi) << 16); }
__device__ __forceinline__ float bflo(unsigned w) { return __builtin_bit_cast(float, w << 16); }
__device__ __forceinline__ float bfhi(unsigned w) { return __builtin_bit_cast(float, w & 0xffff0000u); }
__device__ __forceinline__ float bf1(bf16_t b) { return __builtin_bit_cast(float, (unsigned)b << 16); }
template <int M> __device__ __forceinline__ float sx(float v) { static_assert(M >= 1 && M <= 16, "xor mask inside a 32-lane half"); return __builtin_bit_cast(float, __builtin_amdgcn_ds_swizzle(__builtin_bit_cast(int, v), (M << 10) | 0x1f)); }
__device__ __forceinline__ float half_sum(float v) { const int u = __builtin_bit_cast(int, v); return __builtin_bit_cast(float, __builtin_amdgcn_readlane(u, 0)) + __builtin_bit_cast(float, __builtin_amdgcn_readlane(u, 32)); }
__device__ __forceinline__ float half_max(float v) { const int u = __builtin_bit_cast(int, v); return fmaxf(__builtin_bit_cast(float, __builtin_amdgcn_readlane(u, 0)), __builtin_bit_cast(float, __builtin_amdgcn_readlane(u, 32))); }
__device__ __forceinline__ float wave_sum(float v) { v += sx<1>(v); v += sx<2>(v); v += sx<4>(v); v += sx<8>(v); v += sx<16>(v); return half_sum(v); }
__device__ __forceinline__ float wave_max(float v) { v = fmaxf(v, sx<1>(v)); v = fmaxf(v, sx<2>(v)); v = fmaxf(v, sx<4>(v)); v = fmaxf(v, sx<8>(v)); v = fmaxf(v, sx<16>(v)); return half_max(v); }
__device__ __forceinline__ float dot8(v4u a, v4u b, float s) {
    s = fmaf(bflo(a.x), bflo(b.x), s); s = fmaf(bfhi(a.x), bfhi(b.x), s); s = fmaf(bflo(a.y), bflo(b.y), s); s = fmaf(bfhi(a.y), bfhi(b.y), s);
    s = fmaf(bflo(a.z), bflo(b.z), s); s = fmaf(bfhi(a.z), bfhi(b.z), s); s = fmaf(bflo(a.w), bflo(b.w), s); s = fmaf(bfhi(a.w), bfhi(b.w), s); return s;
}

#define XB_TMO      128
#define XB_XCNT(j)  (256  + 64 * (j))
#define XB_XSUB(j)  (1280 + 64 * (j))
#define XB_XGEN(j)  (2304 + 64 * (j))
#define XB_TOP      3328
#define XB_TOPGEN   3392
#define XCD_BAR_WORDS 3456
#define XB_SPIN_CAP (1u << 22)
__device__ __forceinline__ unsigned xb_ld(unsigned* p)              { return __hip_atomic_load(p, __ATOMIC_RELAXED, __HIP_MEMORY_SCOPE_AGENT); }
__device__ __forceinline__ unsigned xb_add(unsigned* p, unsigned v) { return __hip_atomic_fetch_add(p, v, __ATOMIC_RELAXED, __HIP_MEMORY_SCOPE_AGENT); }
__device__ __forceinline__ unsigned xb_xcc_id() { return (unsigned)__builtin_amdgcn_s_getreg((3 << 11) | 20) & 0xFu; }
#define XB_SPIN(cond, bar) do { unsigned _sp = 0; while (cond) { __builtin_amdgcn_s_sleep(1); \
    if ((++_sp & 255u) == 0u) { if (xb_ld(&(bar)[XB_TMO])) break; if (_sp > XB_SPIN_CAP) { atomicAdd(&(bar)[XB_TMO], 1u); break; } } } } while (0)
struct XcdBarrier { unsigned* bar; unsigned x; volatile LAS unsigned* st; };
__device__ __forceinline__ XcdBarrier xcd_barrier_post(unsigned* bar, volatile LAS unsigned* st, int tid) {
    XcdBarrier b; b.bar = bar; b.x = xb_xcc_id(); b.st = st;
    if (tid == 0) (void)xb_add(&bar[XB_XCNT(b.x)], 1u);
    return b;
}
__device__ __forceinline__ void xcd_barrier_complete(unsigned* bar, unsigned x, unsigned& nloc, unsigned& nx) {
    const unsigned G = gridDim.x * gridDim.y * gridDim.z;
    unsigned sum, cnt, mine, sp = 0u;
    for (;;) {
        sum = 0u; cnt = 0u; mine = 0u;
#pragma unroll
        for (unsigned j = 0; j < 16; ++j) { const unsigned c = xb_ld(&bar[XB_XCNT(j)]); sum += c; cnt += (c > 0u) ? 1u : 0u; mine = (j == x) ? c : mine; }
        if (sum == G) break;
        __builtin_amdgcn_s_sleep(1);
        if ((++sp & 255u) == 0u) { if (xb_ld(&bar[XB_TMO])) break; if (sp > XB_SPIN_CAP) { atomicAdd(&bar[XB_TMO], 1u); break; } }
    }
    nloc = mine > 0u ? mine : 1u; nx = cnt > 0u ? cnt : 1u;
}
__device__ __forceinline__ void xcd_barrier(const XcdBarrier& b, int tid) {
    asm volatile("s_waitcnt vmcnt(0)" ::: "memory");
    __syncthreads();
    if (tid == 0) {
        unsigned* bar = b.bar;
        __builtin_amdgcn_s_waitcnt(0);
        unsigned nloc = b.st[0], nx = b.st[1];
        if (nloc == 0u) { xcd_barrier_complete(bar, b.x, nloc, nx); b.st[0] = nloc; b.st[1] = nx; }
        const unsigned old = xb_add(&bar[XB_XSUB(b.x)], 1u);
        const unsigned gen = old / nloc;
        if (old + 1u == (gen + 1u) * nloc) {
            __builtin_amdgcn_fence(__ATOMIC_RELEASE, "agent");
            asm volatile("s_waitcnt vmcnt(0)" ::: "memory");
            const unsigned og = xb_add(&bar[XB_TOP], 1u);
            const unsigned tg = og / nx;
            if (og + 1u == (tg + 1u) * nx) xb_add(&bar[XB_TOPGEN], 1u);
            else XB_SPIN(xb_ld(&bar[XB_TOPGEN]) == tg, bar);
            __builtin_amdgcn_fence(__ATOMIC_ACQUIRE, "agent");
            xb_add(&bar[XB_XGEN(b.x)], 1u);
            asm volatile("s_waitcnt vmcnt(0)" ::: "memory");
        } else {
            XB_SPIN(xb_ld(&bar[XB_XGEN(b.x)]) == gen, bar);
            __builtin_amdgcn_fence(__ATOMIC_ACQUIRE, "agent");
            asm volatile("s_waitcnt vmcnt(0)" ::: "memory");
        }
    }
    __syncthreads();
}

struct Args { const float* in[N_IN]; float* out; unsigned char* ws; int ph_lo, ph_hi, bar_sel, pad; };
struct Frame {
    LAS unsigned char* lds;
    int tid, lane, wave, G, gw, NGW, bid, wave0;
    const float* const* in; unsigned char* ws; float* out;
};
#define WSP(T, off) ((T*)(F.ws + (off)))

struct WJob { const float* w; bf16_t* o; int ldw, K; bool zero; };
__device__ __forceinline__ WJob wjob_make(const float* W, int ldw, int K, int srccol0, bf16_t* WT, int dstrow0, int kb, bool zero = false) {
    WJob j; j.w = W + (size_t)(64 * kb) * ldw + srccol0; j.o = WT + (size_t)dstrow0 * K + 64 * kb; j.ldw = ldw; j.K = K; j.zero = zero; return j; }
__device__ __forceinline__ void wj_load(const WJob& j, float (&t)[32], int lane) {
    const float* wp = j.w + (size_t)(lane >> 5) * j.ldw + (lane & 31);
#pragma unroll
    for (int i = 0; i < 32; ++i) t[i] = wp[(size_t)(2 * i) * j.ldw];
}
__device__ __forceinline__ void wj_store(const WJob& j, const float (&t)[32], LAS float* scr, int lane) {
#pragma unroll
    for (int i = 0; i < 32; ++i) scr[(2 * i + (lane >> 5)) * 33 + (lane & 31)] = j.zero ? 0.f : t[i];
    LDS_WAIT(); asm volatile("" ::: "memory");
    const int c = lane & 7;
#pragma unroll
    for (int q = 0; q < 4; ++q) { const int n = (lane >> 3) + 8 * q; const LAS float* s = scr + (8 * c) * 33 + n;
        v4u o; o.x = pk2(s[0 * 33], s[1 * 33]); o.y = pk2(s[2 * 33], s[3 * 33]); o.z = pk2(s[4 * 33], s[5 * 33]); o.w = pk2(s[6 * 33], s[7 * 33]);
        *(v4u*)(j.o + (size_t)n * j.K + 8 * c) = o; }
    LDS_WAIT(); asm volatile("" ::: "memory");
}
constexpr int J_GU_RB = 2 * FF / 32, J_GU_KB = DM / 64, J_D_RB = DM / 32, J_D_KB = FF / 64, J_WM_RB = ZLD / 32, J_WH_RB = 1536 / 32, J_IN_KB = DM / 64,
              J_UQ_RB = 1536 / 32, J_UQ_KB = 512 / 64, J_UKV_RB = 2048 / 32, J_UKV_KB = 256 / 64, J_O_RB = DM / 32, J_O_KB = DM / 64;
constexpr int JI_GU = J_GU_RB * J_GU_KB, JI_D = J_D_RB * J_D_KB, JI_WM = J_WM_RB * J_IN_KB, JI_WH = J_WH_RB * J_IN_KB, JI_UQ = J_UQ_RB * J_UQ_KB, JI_UKV = J_UKV_RB * J_UKV_KB, JI_O = J_O_RB * J_O_KB;
constexpr int JI_LAYER = 2 * JI_GU + 2 * JI_D + JI_WM + JI_WH + JI_UQ + JI_UKV + JI_O;
__device__ __forceinline__ WJob wjob_gu(const float* Wg, const float* Wu, bf16_t* dst, int r) {
    const int rb = r / J_GU_KB, kb = r % J_GU_KB, tile = rb >> 3, within = rb & 7;
    return wjob_make(within < 4 ? Wg : Wu, FF, DM, tile * 128 + (within & 3) * 32, dst, rb * 32, kb);
}
__device__ __forceinline__ WJob wjob(const Frame& F, int it) {
    const int l = it / JI_LAYER; int r = it % JI_LAYER;
    unsigned char* wl = F.ws + WS_W + (size_t)l * LW;
    if (r < JI_GU) return wjob_gu(F.in[IN_F1G] + (size_t)l * DM * FF, F.in[IN_F1U] + (size_t)l * DM * FF, (bf16_t*)(wl + LW_GU1), r);
    r -= JI_GU;
    if (r < JI_D) return wjob_make(F.in[IN_F1D] + (size_t)l * FF * DM, DM, FF, (r / J_D_KB) * 32, (bf16_t*)(wl + LW_D1), (r / J_D_KB) * 32, r % J_D_KB);
    r -= JI_D;
    if (r < JI_GU) return wjob_gu(F.in[IN_F2G] + (size_t)l * DM * FF, F.in[IN_F2U] + (size_t)l * DM * FF, (bf16_t*)(wl + LW_GU2), r);
    r -= JI_GU;
    if (r < JI_D) return wjob_make(F.in[IN_F2D] + (size_t)l * FF * DM, DM, FF, (r / J_D_KB) * 32, (bf16_t*)(wl + LW_D2), (r / J_D_KB) * 32, r % J_D_KB);
    r -= JI_D;
    if (r < JI_WM) { const int rb = r / J_IN_KB, kb = r % J_IN_KB, d0 = rb * 32; int src;
        if (d0 < 256) src = d0; else if (d0 < 512) src = 320 + (d0 - 256); else if (d0 < 1024) src = 576 + (d0 - 512); else if (d0 < 1088) src = 256 + (d0 - 1024);
        else if (d0 < 1280) src = -1; else if (d0 < 1792) src = 1088 + (d0 - 1280); else if (d0 < 2048) src = 1600 + (d0 - 1792); else src = 1856 + (d0 - 2048);
        return wjob_make(F.in[IN_WIN] + (size_t)l * DM * 3904, 3904, DM, src < 0 ? 0 : src, (bf16_t*)(wl + LW_WINM), d0, kb, src < 0); }
    r -= JI_WM;
    if (r < JI_WH) { const int rb = r / J_IN_KB, kb = r % J_IN_KB; return wjob_make(F.in[IN_WIN] + (size_t)l * DM * 3904, 3904, DM, 2368 + rb * 32, (bf16_t*)(wl + LW_WINH), rb * 32, kb); }
    r -= JI_WH;
    if (r < JI_UQ) { const int rb = r / J_UQ_KB, kb = r % J_UQ_KB; return wjob_make(F.in[IN_WUQ] + (size_t)l * 512 * 1536, 1536, 512, rb * 32, (bf16_t*)(wl + LW_WUQ), rb * 32, kb); }
    r -= JI_UQ;
    if (r < JI_UKV) { const int rb = r / J_UKV_KB, kb = r % J_UKV_KB; return wjob_make(F.in[IN_WUKV] + (size_t)l * 256 * 2048, 2048, 256, rb * 32, (bf16_t*)(wl + LW_WUKV), rb * 32, kb); }
    r -= JI_UKV;
    { const int rb = r / J_O_KB, kb = r % J_O_KB; return wjob_make(F.in[IN_WOUT] + (size_t)l * DM * DM, DM, DM, rb * 32, (bf16_t*)(wl + LW_WOUT), rb * 32, kb); }
}
__device__ __forceinline__ void p0_weights(const Frame& F) {
    LAS float* scr = (LAS float*)(F.lds + F.wave * 16384);
    constexpr int NIT = 2 * JI_LAYER; const int NPAIR = (NIT + 2 * F.NGW - 1) / (2 * F.NGW);
    int it = F.gw;
    WJob jA = wjob(F, it), jB; float tA[32], tB[32];
    wj_load(jA, tA, F.lane);
    for (int p = 0; p < NPAIR; ++p) {
        int nx = it + F.NGW; nx = nx < NIT ? nx : it;
        jB = wjob(F, nx); wj_load(jB, tB, F.lane);
        wj_store(jA, tA, scr, F.lane);
        it = nx; nx = it + F.NGW; nx = nx < NIT ? nx : it;
        jA = wjob(F, nx); wj_load(jA, tA, F.lane);
        wj_store(jB, tB, scr, F.lane);
        it = nx;
    }
}
__device__ __forceinline__ void p0_modpart(const Frame& F) {
    LAS float* sl = (LAS float*)F.lds;
    for (int it = F.bid; it < 2 * 9 * 8; it += F.G) {
        const int l = it / 72, rem = it % 72, jb = rem / 8, kc = rem % 8;
        __syncthreads();
        for (int idx = F.tid; idx < 9 * 256; idx += NTHR) { const int r = idx >> 8, k = idx & 255;
            const float cv = r < 8 ? F.in[IN_C][r * DM + kc * 256 + k] : F.in[IN_CCTX][kc * 256 + k];
            sl[idx] = cv / (1.0f + expf(-cv)); }
        __syncthreads();
        const int j = jb * 2048 + F.tid * 4;
        const f32x4* wp = (const f32x4*)(F.in[IN_ADAW] + ((size_t)l * DM + kc * 256) * NMODC + j);
        f32x4 acc[9];
#pragma unroll
        for (int r = 0; r < 9; ++r) acc[r] = (f32x4){0.f, 0.f, 0.f, 0.f};
        for (int k = 0; k < 256; k += 8) {
            f32x4 a[8];
#pragma unroll
            for (int q = 0; q < 8; ++q) a[q] = wp[(size_t)(k + q) * (NMODC / 4)];
#pragma unroll
            for (int q = 0; q < 8; ++q)
#pragma unroll
                for (int r = 0; r < 9; ++r) acc[r] = acc[r] + a[q] * sl[r * 256 + k + q];
        }
        float* mp = WSP(float, WS_MOD) + ((size_t)l * 9) * NMODC + j;
        f32x4 bias = (f32x4){0.f, 0.f, 0.f, 0.f}; if (kc == 0) bias = *(const f32x4*)(F.in[IN_ADAB] + l * NMODC + j);
#pragma unroll
        for (int r = 0; r < 9; ++r) { const f32x4 v = acc[r] + bias; float* o = mp + (size_t)r * NMODC;
            unsafeAtomicAdd(o + 0, v[0]); unsafeAtomicAdd(o + 1, v[1]); unsafeAtomicAdd(o + 2, v[2]); unsafeAtomicAdd(o + 3, v[3]); }
    }
    __syncthreads();
}
__device__ __forceinline__ void p0_hyh2(const Frame& F) {
    for (int it = F.gw; it < 2 * 2048 + 256; it += F.NGW) {
        const int l = it < 4096 ? it >> 11 : 0, type = it < 4096 ? 0 : 1, i = it < 4096 ? (it & 2047) : it - 4096, n = type ? 256 : 2048;
        const float t = (float)i / (float)(n - 1), w = (6.2831853071795864f * (float)i) / (float)n;
        float feat = 0.f;
        if (F.lane == 0) feat = t;
        else if (F.lane <= 32) { const int j = (F.lane - 1) & 15; const float f = 1e-4f + (float)j * ((15.0f - 1e-4f) / 15.0f); feat = F.lane <= 16 ? cosf(f * w) : -sinf(f * w); }
        const float* W1 = F.in[IN_HW1] + (size_t)l * 33 * 64; const float* W2 = F.in[IN_HW2] + (size_t)l * 64 * 64;
        float a = F.in[IN_HB1][l * 64 + F.lane];
#pragma unroll
        for (int f = 0; f < 33; ++f) a = fmaf(__shfl(feat, f), W1[f * 64 + F.lane], a);
        const float h1 = sinf(a);
        float b = F.in[IN_HB2][l * 64 + F.lane];
#pragma unroll 8
        for (int k = 0; k < 64; ++k) b = fmaf(__shfl(h1, k), W2[k * 64 + F.lane], b);
        const float h2 = sinf(b);
        float* dst = type ? WSP(float, WS_H2C) + (size_t)i * 64 : WSP(float, WS_H2) + ((size_t)l * 2048 + i) * 64;
        dst[F.lane] = h2;
    }
}
__device__ __forceinline__ void p1_mod(const Frame& F) {
    for (int e = F.bid * NTHR + F.tid; e < 2 * 9 * NMODC; e += F.G * NTHR) {
        const int l = e / (9 * NMODC), rem = e % (9 * NMODC), r = rem / NMODC, j = rem % NMODC;
        float s = F.in[IN_ADAB][l * NMODC + j];
#pragma unroll
        for (int kc = 0; kc < 8; ++kc) s += WSP(float, WS_MODP)[((size_t)(l * 8 + kc) * 9 + r) * NMODC + j];
        WSP(float, WS_MOD)[e] = s;
    }
}
__device__ __forceinline__ void p1_taps(const Frame& F, int sel, int gw, int ngw) {
    LAS float* wl = (LAS float*)(F.lds + F.wave * 8192);
    for (int jt = gw; jt < (sel ? 2048 : 2304); jt += ngw) {
        const int it = jt + 2048 * (sel || jt >= 2048);
        const int type = it < 4096 ? 0 : 1, r = type ? it - 4096 : it, l = type ? 0 : r >> 11, ib = type ? r >> 6 : (r >> 6) & 31, cbk = r & 63, o = cbk >> 5, c0 = (cbk & 31) * 16, n = type ? 256 : 2048;
        const int i = ib * 64 + F.lane;
        const float* h2 = (type ? WSP(float, WS_H2C) : WSP(float, WS_H2) + (size_t)l * 2048 * 64) + (size_t)i * 64;
        f32x4 hv[16];
#pragma unroll
        for (int q = 0; q < 16; ++q) hv[q] = *((const f32x4*)h2 + q);
        const float* W3 = F.in[IN_HW3] + (size_t)l * 64 * 2048 + (size_t)F.lane * 2048 + o * 512 + c0;
#pragma unroll
        for (int dir = 0; dir < 2; ++dir)
#pragma unroll
            for (int q = 0; q < 4; ++q) { const f32x4 w = *((const f32x4*)(W3 + dir * 1024) + q);
#pragma unroll
                for (int e = 0; e < 4; ++e) wl[(dir * 16 + q * 4 + e) * 64 + F.lane] = w[e]; }
        LDS_WAIT(); asm volatile("" ::: "memory");
        const float t = (float)i / (float)(n - 1);
        const float dmin = -3.0701134573f, dmax = -15.350567286f;
        for (int cc = 0; cc < 16; ++cc) {
            float sf = 0.f, sb = 0.f;
            const LAS f32x4* wf = (const LAS f32x4*)(wl + cc * 64); const LAS f32x4* wb = (const LAS f32x4*)(wl + (16 + cc) * 64);
#pragma unroll
            for (int q = 0; q < 16; ++q) { const f32x4 a = wf[q], bq = wb[q], h = hv[q];
                sf = fmaf(h[0], a[0], sf); sf = fmaf(h[1], a[1], sf); sf = fmaf(h[2], a[2], sf); sf = fmaf(h[3], a[3], sf);
                sb = fmaf(h[0], bq[0], sb); sb = fmaf(h[1], bq[1], sb); sb = fmaf(h[2], bq[2], sb); sb = fmaf(h[3], bq[3], sb); }
            const int c = c0 + cc;
            const float delta = fabsf(dmin + (float)c * ((dmax - dmin) / 511.0f)), win = expf(-t * delta) + 0.05f;
            float* dst = type ? WSP(float, WS_TAPSC) + ((size_t)o * 512 + c) * 512 : WSP(float, WS_TAPS) + (((size_t)l * 2 + o) * 512 + c) * 4096;
            if (i == 0) { dst[0] = (sf + sb) * win; dst[n] = 0.f; } else { dst[i] = sf * win; dst[2 * n - i] = sb * win; }
        }
        LDS_WAIT(); asm volatile("" ::: "memory");
    }
}

__device__ __forceinline__ void norm_row(const Frame& F, int row, const float* srcx, const float* srcc, const float* modl, int shift_idx, int scale_idx, bf16_t* dst, const float* part, const float* pgate, float* xout, float pcoef) {
    const float* xr = row < TX ? srcx + (size_t)row * DM : srcc + (size_t)(row - TX) * DM;
    const int mrow = row < TX ? row >> 11 : 8;
    const f32x4* xv = (const f32x4*)xr + F.lane;
    f32x4 v[8]; float ss = 0.f;
#pragma unroll
    for (int j = 0; j < 8; ++j) { v[j] = xv[64 * j]; ss += (v[j][0] * v[j][0] + v[j][1] * v[j][1]) + (v[j][2] * v[j][2] + v[j][3] * v[j][3]); }
    if (part && row >= TX) {
        const f32x4* pp = (const f32x4*)(part + (size_t)(row - TX) * DM) + F.lane; const f32x4* gp = (const f32x4*)pgate + F.lane; f32x4* xo = (f32x4*)(xout + (size_t)(row - TX) * DM) + F.lane;
        ss = 0.f;
#pragma unroll
        for (int j = 0; j < 8; ++j) { const f32x4 s4 = (pp[64 * j] + pp[64 * j + (size_t)TC * DM / 4]) + (pp[64 * j + (size_t)2 * TC * DM / 4] + pp[64 * j + (size_t)3 * TC * DM / 4]);
            v[j] = v[j] + gp[64 * j] * pcoef * s4; xo[64 * j] = v[j]; ss += (v[j][0] * v[j][0] + v[j][1] * v[j][1]) + (v[j][2] * v[j][2] + v[j][3] * v[j][3]); }
    }
    const float rstd = 1.0f / sqrtf(wave_sum(ss) * (1.0f / DM) + EPS);
    const f32x4* sh = (const f32x4*)(modl + (size_t)mrow * NMODC + shift_idx * DM) + F.lane;
    const f32x4* sc = (const f32x4*)(modl + (size_t)mrow * NMODC + scale_idx * DM) + F.lane;
    v2u* o = (v2u*)(dst + (size_t)row * DM) + F.lane;
#pragma unroll
    for (int j = 0; j < 8; ++j) { const f32x4 s = sh[64 * j], c = sc[64 * j]; const f32x4 y = v[j] * rstd * (c + 1.0f) + s;
        v2u w; w.x = pk2(y[0], y[1]); w.y = pk2(y[2], y[3]); o[64 * j] = w; }
}
__device__ __forceinline__ void norm_phase(const Frame& F, const float* srcx, const float* srcc, int nrows, const float* modl, int shift_idx, int scale_idx, bf16_t* dst, const float* part, const float* pgate, float* xout, float pcoef = 0.5f) {
    if (part) {
        for (int r0 = F.bid * 8; r0 < TC; r0 += F.G * 8) {
            const f32x4* pp = (const f32x4*)(part + (size_t)r0 * DM); const f32x4* sc4 = (const f32x4*)(srcc + (size_t)r0 * DM); f32x4* xo = (f32x4*)(xout + (size_t)r0 * DM); const f32x4* gp = (const f32x4*)pgate;
#pragma unroll
            for (int k = 0; k < 8; ++k) { const int idx = F.tid + NTHR * k;
                const f32x4 s4 = (pp[idx] + pp[idx + (size_t)TC * DM / 4]) + (pp[idx + (size_t)2 * TC * DM / 4] + pp[idx + (size_t)3 * TC * DM / 4]);
                xo[idx] = sc4[idx] + gp[idx & 511] * pcoef * s4; }
            VM_WAIT(); __syncthreads();
            norm_row(F, TX + r0 + F.wave, srcx, xout, modl, shift_idx, scale_idx, dst, nullptr, nullptr, nullptr, 0.f);
        }
        if (nrows > TX) nrows = TX;
        part = nullptr;
    }
    LAS f32x4* ms = (LAS f32x4*)F.lds;
    for (int rb0 = F.bid * NWAVES; rb0 < nrows; rb0 += 2 * F.NGW) {
        const int row = rb0 + F.wave, rowb = row + F.NGW; const bool hasb = rb0 + F.NGW < nrows;
        const int ma = rb0 < TX ? rb0 >> 11 : 8, mb = hasb ? (rb0 + F.NGW < TX ? (rb0 + F.NGW) >> 11 : 8) : ma;
        const f32x4* xva = (const f32x4*)(row < TX ? srcx + (size_t)row * DM : srcc + (size_t)(row - TX) * DM) + F.lane;
        const int rowb_c = hasb ? rowb : row;
        const f32x4* xvb = (const f32x4*)(rowb_c < TX ? srcx + (size_t)rowb_c * DM : srcc + (size_t)(rowb_c - TX) * DM) + F.lane;
        f32x4 va[8], vb[8];
#pragma unroll
        for (int j = 0; j < 8; ++j) { va[j] = xva[64 * j]; vb[j] = xvb[64 * j]; }
        __syncthreads();
        { const f32x4* g0 = (const f32x4*)(modl + (size_t)ma * NMODC + shift_idx * DM); const f32x4* g1 = (const f32x4*)(modl + (size_t)ma * NMODC + scale_idx * DM);
          const f32x4* g2 = (const f32x4*)(modl + (size_t)mb * NMODC + shift_idx * DM); const f32x4* g3 = (const f32x4*)(modl + (size_t)mb * NMODC + scale_idx * DM);
          const f32x4 m0 = g0[F.tid], m1 = g1[F.tid], m2 = g2[F.tid], m3 = g3[F.tid];
          ms[F.tid] = m0; ms[512 + F.tid] = m1 + 1.0f; ms[1024 + F.tid] = m2; ms[1536 + F.tid] = m3 + 1.0f; }
        float sa = 0.f, sb = 0.f;
#pragma unroll
        for (int j = 0; j < 8; ++j) { sa += (va[j][0] * va[j][0] + va[j][1] * va[j][1]) + (va[j][2] * va[j][2] + va[j][3] * va[j][3]); sb += (vb[j][0] * vb[j][0] + vb[j][1] * vb[j][1]) + (vb[j][2] * vb[j][2] + vb[j][3] * vb[j][3]); }
        const float ra = 1.0f / sqrtf(wave_sum(sa) * (1.0f / DM) + EPS), rb = 1.0f / sqrtf(wave_sum(sb) * (1.0f / DM) + EPS);
        __syncthreads();
        v2u* oa = (v2u*)(dst + (size_t)row * DM) + F.lane; v2u* ob = (v2u*)(dst + (size_t)rowb_c * DM) + F.lane;
#pragma unroll
        for (int j = 0; j < 8; ++j) { const f32x4 ya = va[j] * ra * ms[512 + F.lane + 64 * j] + ms[F.lane + 64 * j], yb = vb[j] * rb * ms[1536 + F.lane + 64 * j] + ms[1024 + F.lane + 64 * j];
            v2u w; w.x = pk2(ya[0], ya[1]); w.y = pk2(ya[2], ya[3]); oa[64 * j] = w; w.x = pk2(yb[0], yb[1]); w.y = pk2(yb[2], yb[3]); ob[64 * j] = w; }
    }
    __syncthreads();
}

__device__ __forceinline__ float rope_invfreq(int i) { return powf(10000.0f, -(float)i / 16.0f); }
__device__ __forceinline__ void postproj_phase(const Frame& F, int l) {
    const bf16_t* Z = WSP(bf16_t, WS_Z);
    const float* gkv = F.in[IN_KVNORM] + l * 256; const float* gq = F.in[IN_QNORM] + l * 512; const float* gkr = F.in[IN_KNROPE] + l * 64;
    for (int row = F.gw; row < TT; row += F.NGW) {
        const bf16_t* zr = Z + (size_t)row * ZLD;
        {
            const v2u w = *((const v2u*)(zr + ZC_KV) + F.lane);
            const float a0 = bflo(w.x), a1 = bfhi(w.x), a2 = bflo(w.y), a3 = bfhi(w.y);
            const float rstd = 1.0f / sqrtf(wave_sum(a0 * a0 + a1 * a1 + a2 * a2 + a3 * a3) * (1.0f / 256.0f) + EPS);
            const f32x4 g = *((const f32x4*)gkv + F.lane);
            v2u o; o.x = pk2(a0 * rstd * g[0], a1 * rstd * g[1]); o.y = pk2(a2 * rstd * g[2], a3 * rstd * g[3]);
            *((v2u*)(WSP(bf16_t, WS_KVN) + (size_t)row * 256) + F.lane) = o;
        }
        {
            const v4u w = *((const v4u*)(zr + ZC_Q) + F.lane);
            float a[8] = {bflo(w.x), bfhi(w.x), bflo(w.y), bfhi(w.y), bflo(w.z), bfhi(w.z), bflo(w.w), bfhi(w.w)};
            float ss = 0.f;
#pragma unroll
            for (int j = 0; j < 8; ++j) ss += a[j] * a[j];
            const float rstd = 1.0f / sqrtf(wave_sum(ss) * (1.0f / 512.0f) + EPS);
            const f32x4 g0 = *((const f32x4*)gq + 2 * F.lane), g1 = *((const f32x4*)gq + 2 * F.lane + 1);
            v4u o; o.x = pk2(a[0] * rstd * g0[0], a[1] * rstd * g0[1]); o.y = pk2(a[2] * rstd * g0[2], a[3] * rstd * g0[3]);
            o.z = pk2(a[4] * rstd * g1[0], a[5] * rstd * g1[1]); o.w = pk2(a[6] * rstd * g1[2], a[7] * rstd * g1[3]);
            *((v4u*)(WSP(bf16_t, WS_QN) + (size_t)row * 512) + F.lane) = o;
        }
        {
            const float a = bf1(zr[ZC_KR + F.lane]);
            const float rstd = 1.0f / sqrtf(wave_sum(a * a) * (1.0f / 64.0f) + EPS);
            float y = a * rstd * gkr[F.lane];
            if (row < TX) {
                const int t = row & (SEQ - 1), d = F.lane, within = d & 31, i = within & 15;
                const float pos = (float)((d >> 5) ? (t & 63) : (t >> 6));
                const float rev = pos * __builtin_amdgcn_exp2f((float)i * (-13.287712379549449f / 16.0f)) * 0.15915494309189535f;
                const float cs = __builtin_amdgcn_cosf(rev), sn = __builtin_amdgcn_sinf(rev);
                const float other = sx<16>(y);
                y = within < 16 ? y * cs - other * sn : other * sn + y * cs;
            }
            WSP(bf16_t, WS_KROPE)[(size_t)row * 64 + F.lane] = (bf16_t)f2bf(y);
        }
    }
}

constexpr float QSCALE = 0.07216878364870322f * 1.4426950408889634f;
__device__ __forceinline__ void headnorm_phase(const Frame& F, int l) {
    const float* gkn = F.in[IN_KNNOPE] + l * 128; const float* gqn = F.in[IN_QNNOPE] + l * 128; const float* gqr = F.in[IN_QNROPE] + l * 64; const float* gkr = F.in[IN_KNROPE] + l * 64;
    float m1 = fmaxf(fabsf(gkn[F.lane]), fabsf(gkn[64 + F.lane])), m2 = fabsf(gkr[F.lane]);
    m1 = wave_max(m1); m2 = wave_max(m2);
    const float kbound = 1.02f * sqrtf(128.0f * m1 * m1 + 64.0f * m2 * m2);
    const int nq = 0;
    const int h = F.lane >> 3, s8 = F.lane & 7;
    for (int row = F.gw; row < TT; row += F.NGW) {
        {
            v4u* kp = (v4u*)(WSP(bf16_t, WS_KV) + (size_t)row * 2048 + h * 256 + s8 * 16);
            const v4u w0 = kp[0], w1 = kp[1];
            float a[16] = {bflo(w0.x), bfhi(w0.x), bflo(w0.y), bfhi(w0.y), bflo(w0.z), bfhi(w0.z), bflo(w0.w), bfhi(w0.w),
                           bflo(w1.x), bfhi(w1.x), bflo(w1.y), bfhi(w1.y), bflo(w1.z), bfhi(w1.z), bflo(w1.w), bfhi(w1.w)};
            float ss = 0.f;
#pragma unroll
            for (int j = 0; j < 16; ++j) ss += a[j] * a[j];
            ss += sx<1>(ss); ss += sx<2>(ss); ss += sx<4>(ss);
            const float rstd = 1.0f / sqrtf(ss * (1.0f / 128.0f) + EPS);
            const float* g = gkn + s8 * 16;
            v4u o0, o1;
            o0.x = pk2(a[0] * rstd * g[0], a[1] * rstd * g[1]); o0.y = pk2(a[2] * rstd * g[2], a[3] * rstd * g[3]); o0.z = pk2(a[4] * rstd * g[4], a[5] * rstd * g[5]); o0.w = pk2(a[6] * rstd * g[6], a[7] * rstd * g[7]);
            o1.x = pk2(a[8] * rstd * g[8], a[9] * rstd * g[9]); o1.y = pk2(a[10] * rstd * g[10], a[11] * rstd * g[11]); o1.z = pk2(a[12] * rstd * g[12], a[13] * rstd * g[13]); o1.w = pk2(a[14] * rstd * g[14], a[15] * rstd * g[15]);
            kp[0] = o0; kp[1] = o1;
        }
        if (row < nq) {
            bf16_t* qrow = WSP(bf16_t, WS_Q) + (size_t)row * 1536 + h * 192;
            v4u* qp = (v4u*)(qrow + s8 * 16);
            const v4u w0 = qp[0], w1 = qp[1];
            float a[16] = {bflo(w0.x), bfhi(w0.x), bflo(w0.y), bfhi(w0.y), bflo(w0.z), bfhi(w0.z), bflo(w0.w), bfhi(w0.w),
                           bflo(w1.x), bfhi(w1.x), bflo(w1.y), bfhi(w1.y), bflo(w1.z), bfhi(w1.z), bflo(w1.w), bfhi(w1.w)};
            float ss = 0.f;
#pragma unroll
            for (int j = 0; j < 16; ++j) ss += a[j] * a[j];
            ss += sx<1>(ss); ss += sx<2>(ss); ss += sx<4>(ss);
            const float rstd = QSCALE / sqrtf(ss * (1.0f / 128.0f) + EPS);
            const float* g = gqn + s8 * 16;
            float qq = 0.f;
#pragma unroll
            for (int j = 0; j < 16; ++j) { a[j] = a[j] * rstd * g[j]; qq += a[j] * a[j]; }
            v4u o0, o1;
            o0.x = pk2(a[0], a[1]); o0.y = pk2(a[2], a[3]); o0.z = pk2(a[4], a[5]); o0.w = pk2(a[6], a[7]);
            o1.x = pk2(a[8], a[9]); o1.y = pk2(a[10], a[11]); o1.z = pk2(a[12], a[13]); o1.w = pk2(a[14], a[15]);
            qp[0] = o0; qp[1] = o1;
            v4u* rp = (v4u*)(qrow + 128 + s8 * 8);
            const v4u w = rp[0];
            float r[8] = {bflo(w.x), bfhi(w.x), bflo(w.y), bfhi(w.y), bflo(w.z), bfhi(w.z), bflo(w.w), bfhi(w.w)};
            float s2 = 0.f;
#pragma unroll
            for (int j = 0; j < 8; ++j) s2 += r[j] * r[j];
            s2 += sx<1>(s2); s2 += sx<2>(s2); s2 += sx<4>(s2);
            const float rstd2 = 1.0f / sqrtf(s2 * (1.0f / 64.0f) + EPS);
            const int t = row & (SEQ - 1);
#pragma unroll
            for (int j = 0; j < 8; ++j) {
                float y = r[j] * rstd2 * gqr[s8 * 8 + j];
                const float other = sx<2>(y);
                if (row < TX) {
                    const int d = s8 * 8 + j, within = d & 31, i = within & 15;
                    const float pos = (float)((d >> 5) ? (t & 63) : (t >> 6));
                    const float ang = pos * rope_invfreq(i);
                    const float cs = cosf(ang), sn = sinf(ang);
                    y = within < 16 ? y * cs - other * sn : other * sn + y * cs;
                }
                r[j] = y * QSCALE; qq += r[j] * r[j];
            }
            v4u o; o.x = pk2(r[0], r[1]); o.y = pk2(r[2], r[3]); o.z = pk2(r[4], r[5]); o.w = pk2(r[6], r[7]);
            rp[0] = o;
            qq += sx<1>(qq); qq += sx<2>(qq); qq += sx<4>(qq);
            if (s8 == 0) WSP(float, WS_BQ)[(size_t)row * 8 + h] = sqrtf(qq) * kbound;
        }
    }
}


__device__ __forceinline__ int key_row(bool isx, int b, int key) { return isx ? (key < CTXL ? TX + b * CTXL + key : b * SEQ + (key - CTXL)) : TX + b * CTXL + key; }

__device__ __forceinline__ float log2_gamma(const Frame& F, int l, int dir, int h) { const float x = F.in[IN_RDECAY][(l * 2 + dir) * 4 + h]; return -log1pf(expf(-x)) * 1.4426950408889634f; }

__device__ __forceinline__ void ret_naive(const Frame& F, int l) {
    LAS float* dl = (LAS float*)(F.lds + F.wave * 9216);
    const bf16_t* Z = WSP(bf16_t, WS_Z);
    const int nrows = (l == 0) ? TT : TX;
    for (int item = F.gw; item < nrows * 4; item += F.NGW) {
        const int row = item >> 2, h = item & 3; const bool isx = row < TX;
        const int b = isx ? row >> 11 : (row - TX) >> 8, nk = isx ? SEQ + CTXL : CTXL;
        const int tpos = isx ? (row & (SEQ - 1)) : ((row - TX) & (CTXL - 1));
        const v4u* qp = (const v4u*)(Z + (size_t)row * ZLD + ZC_RQ + h * 64);
        for (int i = 0; i < nk / 64; ++i) {
            const int key = i * 64 + F.lane, kr = key_row(isx, b, key);
            const v4u* kp = (const v4u*)(Z + (size_t)kr * ZLD + ZC_RK + h * 64);
            float s = 0.f;
#pragma unroll
            for (int c = 0; c < 8; ++c) s = dot8(qp[c], kp[c], s);
            dl[key] = s * 0.125f;
        }
        LDS_WAIT(); asm volatile("" ::: "memory");
        const float lgf = log2_gamma(F, l, 0, h), lgb = log2_gamma(F, l, 1, h);
        float f0 = 0.f, f1 = 0.f, b0 = 0.f, b1 = 0.f;
        for (int key = 0; key < nk; ++key) {
            const int kr = key_row(isx, b, key);
            const unsigned v2 = *((const unsigned*)(Z + (size_t)kr * ZLD + ZC_RV + h * 128) + F.lane);
            float wf = 0.f, wb = 0.f;
            if (isx) {
                if (key < CTXL) { wf = exp2f((float)(tpos + CTXL - key) * lgf); wb = exp2f((float)(SEQ - tpos + key) * lgb); }
                else { const int s = key - CTXL; if (s <= tpos) wf = exp2f((float)(tpos - s) * lgf); if (s >= tpos) wb = exp2f((float)(s - tpos) * lgb); }
            } else { if (key <= tpos) wf = exp2f((float)(tpos - key) * lgf); if (key >= tpos) wb = exp2f((float)(key - tpos) * lgb); }
            const float d = dl[key]; const float v0 = bflo(v2), v1 = bfhi(v2);
            f0 = fmaf(wf * d, v0, f0); f1 = fmaf(wf * d, v1, f1); b0 = fmaf(wb * d, v0, b0); b1 = fmaf(wb * d, v1, b1);
        }
        bf16_t* ro = WSP(bf16_t, WS_RO) + (size_t)row * 512 + h * 128 + 2 * F.lane;
        *(unsigned*)ro = pk2(f0, f1); *(unsigned*)(ro + (size_t)TT * 512) = pk2(b0, b1);
        LDS_WAIT(); asm volatile("" ::: "memory");
    }
}

__device__ __forceinline__ void hyena_ctx(const Frame& F, int l) {
    if (l != 0) return;
    LAS float* base = (LAS float*)(F.lds + F.wave * 8192);
    LAS float* sin_ = base; LAS float* sy = base + 256; LAS float* tp = base + 512;
    const bf16_t* ZT = WSP(bf16_t, WS_ZT);
    const float* cw = F.in[IN_HCW]; const float* cb = F.in[IN_HCB]; const float* skip = F.in[IN_HSKIP];
    const int t0 = 4 * F.lane;
    for (int it = F.gw; it < NB * 512; it += F.NGW) {
        const int b = it >> 9, c = it & 511, col0 = TX + b * CTXL;
        float gx1[4], gx2[4], vv[4];
#pragma unroll
        for (int g = 0; g < 3; ++g) { const int j = g * 512 + c; const bf16_t* rp = ZT + (size_t)j * TT + col0;
            const v2u w = *(const v2u*)(rp + t0);
            const float u0 = bflo(w.x), u1 = bfhi(w.x), u2 = bflo(w.y), u3 = bfhi(w.y);
            const float um = t0 > 0 ? bf1(rp[t0 - 1]) : 0.f, up = t0 + 4 < CTXL ? bf1(rp[t0 + 4]) : 0.f;
            const float w0 = cw[j], w1 = cw[1536 + j], w2 = cw[2 * 1536 + j], bs = cb[j];
            float o[4] = {w0 * um + w1 * u0 + w2 * u1 + bs, w0 * u0 + w1 * u1 + w2 * u2 + bs, w0 * u1 + w1 * u2 + w2 * u3 + bs, w0 * u2 + w1 * u3 + w2 * up + bs};
#pragma unroll
            for (int e = 0; e < 4; ++e) { if (g == 0) gx1[e] = o[e]; else if (g == 1) gx2[e] = o[e]; else vv[e] = o[e]; } }
        *(LAS f32x4*)(sin_ + t0) = (f32x4){vv[0], vv[1], vv[2], vv[3]};
#pragma unroll
        for (int o = 0; o < 2; ++o) {
            const float* tg = WSP(float, WS_TAPSC) + ((size_t)o * 512 + c) * 512;
            *(LAS f32x4*)(tp + 8 * F.lane) = *(const f32x4*)(tg + 8 * F.lane); *(LAS f32x4*)(tp + 8 * F.lane + 4) = *(const f32x4*)(tg + 8 * F.lane + 4);
            LDS_WAIT(); asm volatile("" ::: "memory");
            const LAS float* in = o ? sy : sin_; const float sk = skip[o * 512 + c];
            float acc[4] = {0.f, 0.f, 0.f, 0.f};
#pragma unroll 4
            for (int m = 0; m < CTXL / 4; ++m) {
                const f32x4 u = *(const LAS f32x4*)(in + 4 * m);
                const int d0 = (t0 - 4 * m) & 511;
                const f32x4 hi = *(const LAS f32x4*)(tp + d0), lo = *(const LAS f32x4*)(tp + ((d0 - 4) & 511));
                const float w[7] = {lo[1], lo[2], lo[3], hi[0], hi[1], hi[2], hi[3]};
#pragma unroll
                for (int k = 0; k < 4; ++k)
#pragma unroll
                    for (int j = 0; j < 4; ++j) acc[k] = fmaf(w[3 + k - j], u[j], acc[k]);
            }
            const f32x4 iv = *(const LAS f32x4*)(in + t0);
            float y[4];
#pragma unroll
            for (int k = 0; k < 4; ++k) y[k] = (o ? gx2[k] : gx1[k]) * (acc[k] + sk * iv[k]);
            LDS_WAIT(); asm volatile("" ::: "memory");
            if (o == 0) *(LAS f32x4*)(sy + t0) = (f32x4){y[0], y[1], y[2], y[3]};
            else { v2u w; w.x = pk2(y[0], y[1]); w.y = pk2(y[2], y[3]); *(v2u*)(WSP(bf16_t, WS_HY) + (size_t)c * TT + col0 + t0) = w; }
            LDS_WAIT(); asm volatile("" ::: "memory");
        }
    }
}

template <int RW> __device__ __forceinline__ void merge_rows(const Frame& F, int l, int nrows) {
    LAS float* hy_s = (LAS float*)F.lds;
    const float* gout = F.in[IN_OUTNORM] + l * 1024; const float* ghy = F.in[IN_HONORM] + l * 512; const float* gnw = F.in[IN_RGNW] + l * 512; const float* gnb = F.in[IN_RGNB] + l * 512;
    for (int tile = F.bid; tile < nrows / (8 * RW); tile += F.G) {
      v4u hv[RW], aw0[RW], aw1[RW], rx0[RW], rx1[RW], gwv[RW];
      { const v4u* hp = (const v4u*)(WSP(bf16_t, WS_HY) + (size_t)F.tid * TT + tile * (8 * RW));
#pragma unroll
        for (int q = 0; q < RW; ++q) hv[q] = hp[q]; }
#pragma unroll
      for (int r4 = 0; r4 < RW; ++r4) { const int row = tile * (8 * RW) + RW * F.wave + r4;
        const v4u* ap = (const v4u*)(WSP(bf16_t, WS_AO) + (size_t)row * 1024 + F.lane * 16); aw0[r4] = ap[0]; aw1[r4] = ap[1];
        const bf16_t* r0 = WSP(bf16_t, WS_RO) + (size_t)row * 512 + F.lane * 8; rx0[r4] = *(const v4u*)r0; rx1[r4] = *(const v4u*)(r0 + (size_t)TT * 512);
        gwv[r4] = *((const v4u*)(WSP(bf16_t, WS_Z) + (size_t)row * ZLD + ZC_RG) + F.lane); }
      __syncthreads();
#pragma unroll
      for (int q = 0; q < RW; ++q) { const v4u v = hv[q]; LAS float* d = hy_s + F.tid * 33 + 8 * q;
          d[0] = bflo(v.x); d[1] = bfhi(v.x); d[2] = bflo(v.y); d[3] = bfhi(v.y); d[4] = bflo(v.z); d[5] = bfhi(v.z); d[6] = bflo(v.w); d[7] = bfhi(v.w); }
      __syncthreads();
#pragma unroll
      for (int r4 = 0; r4 < RW; ++r4) {
        const int rr = RW * F.wave + r4, row = tile * (8 * RW) + rr;
        bf16_t* mr = WSP(bf16_t, WS_HMOD) + (size_t)row * DM;
        {
            const v4u w0 = aw0[r4], w1 = aw1[r4];
            float a[16] = {bflo(w0.x), bfhi(w0.x), bflo(w0.y), bfhi(w0.y), bflo(w0.z), bfhi(w0.z), bflo(w0.w), bfhi(w0.w),
                           bflo(w1.x), bfhi(w1.x), bflo(w1.y), bfhi(w1.y), bflo(w1.z), bfhi(w1.z), bflo(w1.w), bfhi(w1.w)};
            float ss = 0.f;
#pragma unroll
            for (int j = 0; j < 16; ++j) ss += a[j] * a[j];
            const float rstd = 1.0f / sqrtf(wave_sum(ss) * (1.0f / 1024.0f) + EPS);
            const float* g = gout + F.lane * 16;
            v4u o0, o1;
            o0.x = pk2(a[0] * rstd * g[0], a[1] * rstd * g[1]); o0.y = pk2(a[2] * rstd * g[2], a[3] * rstd * g[3]); o0.z = pk2(a[4] * rstd * g[4], a[5] * rstd * g[5]); o0.w = pk2(a[6] * rstd * g[6], a[7] * rstd * g[7]);
            o1.x = pk2(a[8] * rstd * g[8], a[9] * rstd * g[9]); o1.y = pk2(a[10] * rstd * g[10], a[11] * rstd * g[11]); o1.z = pk2(a[12] * rstd * g[12], a[13] * rstd * g[13]); o1.w = pk2(a[14] * rstd * g[14], a[15] * rstd * g[15]);
            v4u* op = (v4u*)(mr + F.lane * 16); op[0] = o0; op[1] = o1;
        }
        {
            float a[8]; float ss = 0.f;
#pragma unroll
            for (int j = 0; j < 8; ++j) { a[j] = hy_s[(F.lane + 64 * j) * 33 + rr]; ss += a[j] * a[j]; }
            const float rstd = 1.0f / sqrtf(wave_sum(ss) * (1.0f / 512.0f) + EPS);
#pragma unroll
            for (int j = 0; j < 8; ++j) mr[1024 + F.lane + 64 * j] = (bf16_t)f2bf(a[j] * rstd * ghy[F.lane + 64 * j]);
        }
        {
            const v4u x0 = rx0[r4], x1 = rx1[r4];
            float a[8] = {bflo(x0.x) + bflo(x1.x), bfhi(x0.x) + bfhi(x1.x), bflo(x0.y) + bflo(x1.y), bfhi(x0.y) + bfhi(x1.y), bflo(x0.z) + bflo(x1.z), bfhi(x0.z) + bfhi(x1.z), bflo(x0.w) + bflo(x1.w), bfhi(x0.w) + bfhi(x1.w)};
            float s = 0.f;
#pragma unroll
            for (int j = 0; j < 8; ++j) s += a[j];
            s += sx<1>(s); s += sx<2>(s); s += sx<4>(s); s += sx<8>(s);
            const float mu = s * (1.0f / 128.0f); float q = 0.f;
#pragma unroll
            for (int j = 0; j < 8; ++j) { a[j] -= mu; q += a[j] * a[j]; }
            q += sx<1>(q); q += sx<2>(q); q += sx<4>(q); q += sx<8>(q);
            const float rstd = 1.0f / sqrtf(q * (1.0f / 128.0f) + EPS);
            const v4u gw = gwv[r4];
            const float gt[8] = {bflo(gw.x), bfhi(gw.x), bflo(gw.y), bfhi(gw.y), bflo(gw.z), bfhi(gw.z), bflo(gw.w), bfhi(gw.w)};
            float y[8];
#pragma unroll
            for (int j = 0; j < 8; ++j) { const float o = a[j] * rstd * gnw[F.lane * 8 + j] + gnb[F.lane * 8 + j]; const float gg = gt[j]; y[j] = gg / (1.0f + expf(-gg)) * o; }
            v4u o; o.x = pk2(y[0], y[1]); o.y = pk2(y[2], y[3]); o.z = pk2(y[4], y[5]); o.w = pk2(y[6], y[7]);
            *((v4u*)(mr + 1536) + F.lane) = o;
        }
      }
    }
    __syncthreads();
}
__device__ __forceinline__ void merge_phase(const Frame& F, int l) {
    if (l == 0) merge_rows<3>(F, l, TT);
    else merge_rows<4>(F, l, TX);
}

namespace att {
typedef short bf16x8 __attribute__((ext_vector_type(8)));
typedef short s16x4 __attribute__((ext_vector_type(4)));
typedef float f32x16 __attribute__((ext_vector_type(16)));
typedef unsigned u32x4 __attribute__((ext_vector_type(4)));
constexpr int KROW = 400;
constexpr int SHM_K = 64 * KROW, SHM_V = 64 * 128 * 2;
constexpr int OFF_V = 0, OFF_K = 2 * SHM_V, OFF_WS = OFF_K + 2 * SHM_K, ATT_LDS = OFF_WS + 8 * 256;
static_assert(ATT_LDS <= RING_BYTES, "attention LDS");
#define ATT_SBAR() __builtin_amdgcn_sched_barrier(0)
__device__ __forceinline__ int crow(int r, int hi) { return (r & 3) + 8 * (r >> 2) + 4 * hi; }
__device__ __forceinline__ unsigned cvtpk(float lo, float hi) { unsigned r; asm volatile("v_cvt_pk_bf16_f32 %0, %1, %2" : "=v"(r) : "v"(lo), "v"(hi)); return r; }
__device__ __forceinline__ int v_st(int k, int c) { const int kk = (k & ~0xC) | ((k & 4) << 1) | ((k & 8) >> 1); return ((kk >> 3) * 4 + (c >> 5)) * 512 + ((kk & 7) * 32 + (c & 31)) * 2; }
__device__ __forceinline__ int v_rd_base(int lane) { return ((lane & 3) << 3) | (((lane >> 2) & 3) << 6) | (((lane >> 4) & 1) << 5) | (((lane >> 5) & 1) << 8); }
constexpr int v_rd_off(int d0, int ks, int half) { return d0 * 512 + ks * 4096 + half * 2048; }
template <int OFF> __device__ __forceinline__ s16x4 tr_read(int vb) { s16x4 r; asm volatile("ds_read_b64_tr_b16 %0, %1 offset:%2" : "=&v"(r) : "v"(vb), "i"(OFF) : "memory"); return r; }
template <int D0> __device__ __forceinline__ void pv_one(f32x16& od, int vb, bf16x8 pa0, bf16x8 pa1, bf16x8 pa2, bf16x8 pa3) {
    const s16x4 l0 = tr_read<v_rd_off(D0, 0, 0)>(vb), h0 = tr_read<v_rd_off(D0, 0, 1)>(vb), l1 = tr_read<v_rd_off(D0, 1, 0)>(vb), h1 = tr_read<v_rd_off(D0, 1, 1)>(vb);
    const s16x4 l2 = tr_read<v_rd_off(D0, 2, 0)>(vb), h2 = tr_read<v_rd_off(D0, 2, 1)>(vb), l3 = tr_read<v_rd_off(D0, 3, 0)>(vb), h3 = tr_read<v_rd_off(D0, 3, 1)>(vb);
    asm volatile("s_waitcnt lgkmcnt(0)" ::: "memory"); ATT_SBAR();
#define ATT_PK(L, H) (bf16x8){L[0], L[1], L[2], L[3], H[0], H[1], H[2], H[3]}
    od = __builtin_amdgcn_mfma_f32_32x32x16_bf16(pa0, ATT_PK(l0, h0), od, 0, 0, 0);
    od = __builtin_amdgcn_mfma_f32_32x32x16_bf16(pa1, ATT_PK(l1, h1), od, 0, 0, 0);
    od = __builtin_amdgcn_mfma_f32_32x32x16_bf16(pa2, ATT_PK(l2, h2), od, 0, 0, 0);
    od = __builtin_amdgcn_mfma_f32_32x32x16_bf16(pa3, ATT_PK(l3, h3), od, 0, 0, 0);
#undef ATT_PK
}
template <int OFF> __device__ __forceinline__ bf16x8 lds_read128(int addr) { bf16x8 r; asm volatile("ds_read_b128 %0, %1 offset:%2" : "=&v"(r) : "v"(addr), "i"(OFF) : "memory"); return r; }
__device__ __forceinline__ void qkt(f32x16& p0, f32x16& p1, float negB, int kaddr, const bf16x8 (&qr)[12]) {
#pragma unroll
    for (int r = 0; r < 16; ++r) { p0[r] = negB; p1[r] = negB; }
    constexpr int B0 = 0, B1 = 32 * KROW;
    bf16x8 a0[3], a1[3], c0[3], c1[3];
#define ATT_LDG(X0, X1, G) do { X0[0] = lds_read128<B0 + (3 * (G) + 0) * 32>(kaddr); X1[0] = lds_read128<B1 + (3 * (G) + 0) * 32>(kaddr); X0[1] = lds_read128<B0 + (3 * (G) + 1) * 32>(kaddr); \
        X1[1] = lds_read128<B1 + (3 * (G) + 1) * 32>(kaddr); X0[2] = lds_read128<B0 + (3 * (G) + 2) * 32>(kaddr); X1[2] = lds_read128<B1 + (3 * (G) + 2) * 32>(kaddr); } while (0)
#define ATT_MMG(X0, X1, G) do { _Pragma("unroll") for (int i = 0; i < 3; ++i) { p0 = __builtin_amdgcn_mfma_f32_32x32x16_bf16(X0[i], qr[3 * (G) + i], p0, 0, 0, 0); \
        p1 = __builtin_amdgcn_mfma_f32_32x32x16_bf16(X1[i], qr[3 * (G) + i], p1, 0, 0, 0); } } while (0)
    ATT_LDG(a0, a1, 0);
    ATT_LDG(c0, c1, 1); asm volatile("s_waitcnt lgkmcnt(6)" ::: "memory"); ATT_SBAR(); ATT_MMG(a0, a1, 0); ATT_SBAR();
    ATT_LDG(a0, a1, 2); asm volatile("s_waitcnt lgkmcnt(6)" ::: "memory"); ATT_SBAR(); ATT_MMG(c0, c1, 1); ATT_SBAR();
    ATT_LDG(c0, c1, 3); asm volatile("s_waitcnt lgkmcnt(6)" ::: "memory"); ATT_SBAR(); ATT_MMG(a0, a1, 2); ATT_SBAR();
    asm volatile("s_waitcnt lgkmcnt(0)" ::: "memory"); ATT_SBAR(); ATT_MMG(c0, c1, 3); ATT_SBAR();
#undef ATT_LDG
#undef ATT_MMG
}
__device__ __forceinline__ void softmax_pack(f32x16& p0, f32x16& p1, float& l_reg, bf16x8& pa0, bf16x8& pa1, bf16x8& pa2, bf16x8& pa3) {
#pragma unroll
    for (int r = 0; r < 16; ++r) { p0[r] = __builtin_amdgcn_exp2f(p0[r]); p1[r] = __builtin_amdgcn_exp2f(p1[r]); }
    float ps = 0.f;
#pragma unroll
    for (int r = 0; r < 16; ++r) ps += p0[r] + p1[r];
    l_reg += ps;
#define ATT_PK4(P, BASE, OUT) do { unsigned a0 = cvtpk(P[BASE + 0], P[BASE + 1]), a1 = cvtpk(P[BASE + 2], P[BASE + 3]);   \
    unsigned b0 = cvtpk(P[BASE + 4], P[BASE + 5]), b1 = cvtpk(P[BASE + 6], P[BASE + 7]);                              \
    auto r0 = __builtin_amdgcn_permlane32_swap(a0, b0, false, false); auto r1 = __builtin_amdgcn_permlane32_swap(a1, b1, false, false); \
    u32x4 w = {r0[0], r1[0], r0[1], r1[1]}; OUT = *reinterpret_cast<bf16x8*>(&w); } while (0)
    ATT_PK4(p0, 0, pa0); ATT_PK4(p0, 8, pa1); ATT_PK4(p1, 0, pa2); ATT_PK4(p1, 8, pa3);
#undef ATT_PK4
}
__device__ __forceinline__ void v_inv(int x, int& k, int& c) { const int sub = x >> 9, within = x & 511, kk = (sub >> 2) * 8 + (within >> 6); k = (kk & ~0xC) | ((kk & 4) << 1) | ((kk & 8) >> 1); c = (sub & 3) * 32 + ((within & 63) >> 1); }

__device__ __forceinline__ void attn_unit(const bf16_t* Qb, const float* gqn, const float* gqr, float kbound, int tpos0, const bf16_t* KVh, const bf16_t* KR, bf16_t* Ob, int rowc, int rowx, int NT, LAS char* lds, int tid_in) {
    int tid = tid_in; asm volatile("" : "+v"(tid));
    const int wid = __builtin_amdgcn_readfirstlane(tid >> 6), lane = tid & 63, r32 = lane & 31, hi = lane >> 5;
    LAS float* li_l = (LAS float*)(lds + OFF_WS + wid * 256);
    float l_reg = 0.f; f32x16 o[4];
#pragma unroll
    for (int d = 0; d < 4; ++d)
#pragma unroll
        for (int r = 0; r < 16; ++r) o[d][r] = 0.f;
    bf16x8 qr[12];
    { const bf16_t* Qw = Qb + (size_t)(wid * 32 + r32) * 1536 + hi * 8;
#pragma unroll
      for (int d0 = 0; d0 < 12; ++d0) qr[d0] = *(const bf16x8*)(Qw + d0 * 16); }
    float negB;
    {   LAS float* xs = (LAS float*)(lds + OFF_WS + wid * 256);
        float ssn = 0.f, ssr = 0.f;
#pragma unroll
        for (int d0 = 0; d0 < 12; ++d0)
#pragma unroll
            for (int j = 0; j < 8; ++j) { const float x = bf1((bf16_t)qr[d0][j]); if (d0 < 8) ssn += x * x; else ssr += x * x; }
        xs[lane] = ssn; asm volatile("s_waitcnt lgkmcnt(0)" ::: "memory"); ssn += xs[lane ^ 32]; asm volatile("s_waitcnt lgkmcnt(0)" ::: "memory");
        xs[lane] = ssr; asm volatile("s_waitcnt lgkmcnt(0)" ::: "memory"); ssr += xs[lane ^ 32]; asm volatile("s_waitcnt lgkmcnt(0)" ::: "memory");
        const float rn = QSCALE / sqrtf(ssn * (1.0f / 128.0f) + EPS), rr = 1.0f / sqrtf(ssr * (1.0f / 64.0f) + EPS);
        float qq = 0.f;
#pragma unroll
        for (int d0 = 0; d0 < 8; ++d0) { const f32x4 g0 = *(const f32x4*)(gqn + d0 * 16 + hi * 8), g1 = *(const f32x4*)(gqn + d0 * 16 + hi * 8 + 4);
#pragma unroll
            for (int j = 0; j < 8; ++j) { const float y = bf1((bf16_t)qr[d0][j]) * rn * (j < 4 ? g0[j & 3] : g1[j & 3]); qq += y * y; qr[d0][j] = (short)f2bf(y); } }
        const int t = tpos0 + wid * 32 + r32;
#pragma unroll
        for (int seg = 0; seg < 2; ++seg) { const int a = 8 + 2 * seg; const float pos = (float)(seg ? (t & 63) : (t >> 6));
            const f32x4 ga0 = *(const f32x4*)(gqr + (a - 8) * 16 + hi * 8), ga1 = *(const f32x4*)(gqr + (a - 8) * 16 + hi * 8 + 4), gb0 = *(const f32x4*)(gqr + (a - 7) * 16 + hi * 8), gb1 = *(const f32x4*)(gqr + (a - 7) * 16 + hi * 8 + 4);
#pragma unroll
            for (int j = 0; j < 8; ++j) {
                const float x1 = bf1((bf16_t)qr[a][j]) * rr * (j < 4 ? ga0[j & 3] : ga1[j & 3]), x2 = bf1((bf16_t)qr[a + 1][j]) * rr * (j < 4 ? gb0[j & 3] : gb1[j & 3]);
                float y1 = x1, y2 = x2;
                if (tpos0 >= 0) { const float rev = pos * __builtin_amdgcn_exp2f((float)(hi * 8 + j) * (-13.287712379549449f / 16.0f)) * 0.15915494309189535f;
                    const float cs = __builtin_amdgcn_cosf(rev), sn = __builtin_amdgcn_sinf(rev); y1 = x1 * cs - x2 * sn; y2 = x1 * sn + x2 * cs; }
                y1 *= QSCALE; y2 *= QSCALE; qq += y1 * y1 + y2 * y2;
                qr[a][j] = (short)f2bf(y1); qr[a + 1][j] = (short)f2bf(y2); } }
        xs[lane] = qq; asm volatile("s_waitcnt lgkmcnt(0)" ::: "memory"); qq += xs[lane ^ 32]; asm volatile("s_waitcnt lgkmcnt(0)" ::: "memory");
        negB = -sqrtf(qq) * kbound;
    }
    unsigned vsrc[2], ksrc[4]; bool krope[4];
#pragma unroll
    for (int i = 0; i < 2; ++i) { int k, c; v_inv((wid * 2 + i) * 1024 + lane * 16, k, c); vsrc[i] = (unsigned)(k * 4096 + (128 + c) * 2); }
#pragma unroll
    for (int i = 0; i < 4; ++i) { const int x = (wid + 8 * i) * 1024 + lane * 16, row = x / KROW, cb = x % KROW;
        krope[i] = (cb >= 256 && cb < 384); ksrc[i] = krope[i] ? (unsigned)(row * 128 + (cb - 256)) : (unsigned)(row * 4096 + (cb < 256 ? cb : 0)); }
    const int kaddr = (int)(unsigned)(size_t)lds + OFF_K + r32 * KROW + hi * 16;
    const int vb0 = (int)(unsigned)(size_t)lds + OFF_V + v_rd_base(lane);
#define ATT_ISSUE(BUF, t) do { const int row0_ = (t) < 4 ? rowc + 64 * (t) : rowx + 64 * ((t) - 4); \
        const char* kvb_ = (const char*)KVh + (size_t)row0_ * 4096; const char* krb_ = (const char*)KR + (size_t)row0_ * 128; \
        _Pragma("unroll") for (int i_ = 0; i_ < 2; ++i_) __builtin_amdgcn_global_load_lds((const unsigned*)(kvb_ + vsrc[i_]), (LAS unsigned*)(lds + OFF_V + (BUF) * SHM_V + (wid * 2 + i_) * 1024), 16, 0, 0); \
        _Pragma("unroll") for (int i_ = 0; i_ < 3; ++i_) __builtin_amdgcn_global_load_lds((const unsigned*)((krope[i_] ? krb_ : kvb_) + ksrc[i_]), (LAS unsigned*)(lds + OFF_K + (BUF) * SHM_K + (wid + 8 * i_) * 1024), 16, 0, 0); \
        if (wid == 0) __builtin_amdgcn_global_load_lds((const unsigned*)((krope[3] ? krb_ : kvb_) + ksrc[3]), (LAS unsigned*)(lds + OFF_K + (BUF) * SHM_K + 24 * 1024), 16, 0, 0); } while (0)
#define ATT_TILE_DONE() do { asm volatile("s_waitcnt vmcnt(0)" ::: "memory"); __builtin_amdgcn_s_barrier(); asm volatile("" ::: "memory"); } while (0)
    f32x16 p0, p1; bf16x8 pa0, pa1, pa2, pa3;
    ATT_ISSUE(0, 0); ATT_TILE_DONE();
    for (int j = 0; j < NT; j += 2) {
        ATT_ISSUE(1, j + 1);
        ATT_SBAR(); qkt(p0, p1, negB, kaddr, qr);
        softmax_pack(p0, p1, l_reg, pa0, pa1, pa2, pa3); ATT_SBAR();
        pv_one<0>(o[0], vb0, pa0, pa1, pa2, pa3); pv_one<1>(o[1], vb0, pa0, pa1, pa2, pa3); pv_one<2>(o[2], vb0, pa0, pa1, pa2, pa3); pv_one<3>(o[3], vb0, pa0, pa1, pa2, pa3);
        ATT_TILE_DONE();
        if (j + 2 < NT) ATT_ISSUE(0, j + 2);
        ATT_SBAR(); qkt(p0, p1, negB, kaddr + SHM_K, qr);
        softmax_pack(p0, p1, l_reg, pa0, pa1, pa2, pa3); ATT_SBAR();
        pv_one<0>(o[0], vb0 + SHM_V, pa0, pa1, pa2, pa3); pv_one<1>(o[1], vb0 + SHM_V, pa0, pa1, pa2, pa3); pv_one<2>(o[2], vb0 + SHM_V, pa0, pa1, pa2, pa3); pv_one<3>(o[3], vb0 + SHM_V, pa0, pa1, pa2, pa3);
        ATT_TILE_DONE();
    }
#undef ATT_ISSUE
#undef ATT_TILE_DONE
    li_l[lane] = l_reg;
    asm volatile("s_waitcnt lgkmcnt(0)" ::: "memory");
    int lane2 = lane; asm volatile("" : "+v"(lane2));
    const int r32e = lane2 & 31, hie = lane2 >> 5;
    LAS char* st = lds + wid * (32 * 272);
#pragma unroll
    for (int r = 0; r < 16; ++r) { const int orow = (r & 3) + 8 * (r >> 2); const float rl = __builtin_amdgcn_rcpf(li_l[orow + 4 * hie] + li_l[32 + orow + 4 * hie]);
#pragma unroll
        for (int d0 = 0; d0 < 4; ++d0) *(LAS bf16_t*)(st + (orow + 4 * hie) * 272 + (d0 * 32 + r32e) * 2) = (bf16_t)f2bf(o[d0][r] * rl); }
    asm volatile("s_waitcnt lgkmcnt(0)" ::: "memory");
    bf16_t* Ow = Ob + (size_t)(wid * 32) * 1024;
#pragma unroll
    for (int k = 0; k < 8; ++k) { const int p = lane2 + 64 * k, prow = p >> 4, pc = p & 15;
        const u32x4 v = *(const LAS u32x4*)(st + prow * 272 + pc * 16);
        *(u32x4*)(Ow + (size_t)prow * 1024 + pc * 8) = v; }
    asm volatile("s_waitcnt lgkmcnt(0)" ::: "memory");
}
}

__device__ __forceinline__ void attn_phase(const Frame& F, int l) {
    const int nitems = (l == 0) ? 512 + 64 : 512;
    const int vcu = (F.G % 8 == 0) ? (F.bid % 8) * (F.G / 8) + F.bid / 8 : F.bid;
    const bf16_t* Q = WSP(bf16_t, WS_Q); const bf16_t* KV = WSP(bf16_t, WS_KV); const bf16_t* KR = WSP(bf16_t, WS_KROPE); bf16_t* AO = WSP(bf16_t, WS_AO);
    const float* gkn = F.in[IN_KNNOPE] + l * 128; const float* gkr = F.in[IN_KNROPE] + l * 64; const float* gqn = F.in[IN_QNNOPE] + l * 128; const float* gqr = F.in[IN_QNROPE] + l * 64;
    float m1 = fmaxf(fabsf(gkn[F.lane]), fabsf(gkn[64 + F.lane])), m2 = fabsf(gkr[F.lane]);
    m1 = wave_max(m1); m2 = wave_max(m2);
    const float kbound = 1.02f * sqrtf(128.0f * m1 * m1 + 64.0f * m2 * m2);
    for (int item = vcu; item < nitems; item += F.G) {
        int b, h, row0, NT, tpos0;
        if (item < 512) { const int bh = item >> 3, qb = item & 7; b = bh >> 3; h = bh & 7; row0 = b * SEQ + qb * 256; NT = (SEQ + CTXL) / 64; tpos0 = qb * 256; }
        else { const int bh = item - 512; b = bh >> 3; h = bh & 7; row0 = TX + b * CTXL; NT = CTXL / 64; tpos0 = -1; }
        __syncthreads();
        att::attn_unit(Q + (size_t)row0 * 1536 + h * 192, gqn, gqr, kbound, tpos0, KV + h * 256, KR, AO + (size_t)row0 * 1024 + h * 128, TX + b * CTXL, b * SEQ, NT, (LAS char*)F.lds, F.tid);
    }
    __syncthreads();
}

namespace ret {
typedef short bf16x8 __attribute__((ext_vector_type(8)));
typedef float f32x4 __attribute__((ext_vector_type(4)));
constexpr int QS = 144, TS = 272;
constexpr int OFF_Q = 0, OFF_K = OFF_Q + 128 * QS, OFF_KT = OFF_K + 128 * QS, OFF_VT = OFF_KT + 64 * TS, OFF_A = OFF_VT + 32 * TS, OFF_ST = OFF_A + 128 * TS, RET_LDS = OFF_ST + 32 * QS;
static_assert(RET_LDS <= RING_BYTES, "retention LDS");
__device__ __forceinline__ bf16x8 ldsv(const LAS char* p) { return *(const LAS bf16x8*)p; }

__device__ __forceinline__ void ret_item(const Frame& F, int l, int b, int h, int dir, int dvq) {
    LAS char* lds = (LAS char*)F.lds;
    int tid = F.tid; asm volatile("" : "+v"(tid));
    const int w = __builtin_amdgcn_readfirstlane(tid >> 6), lane = tid & 63, lr = lane & 15, g = lane >> 4;
    const bf16_t* Z = WSP(bf16_t, WS_Z);
    const float lg2 = log2_gamma(F, l, dir, h);
    const float cd = __builtin_amdgcn_exp2f(128.0f * lg2);
    f32x4 S = {0.f, 0.f, 0.f, 0.f};
    const int qrow0 = tid >> 3, qc8 = tid & 7, vrow = tid >> 2, vc4 = tid & 3;
    v4u rq[2], rk[2], rv;
#define RET_ROW0(p) ((p) < 2 ? TX + b * CTXL + 128 * (dir ? 1 - (p) : (p)) : b * SEQ + 128 * (dir ? 17 - (p) : (p) - 2))
#define RET_LOAD(p) do { const int r0_ = RET_ROW0(p); \
        _Pragma("unroll") for (int k_ = 0; k_ < 2; ++k_) { const bf16_t* zr_ = Z + (size_t)(r0_ + qrow0 + 64 * k_) * ZLD + h * 64 + qc8 * 8; rq[k_] = *(const v4u*)(zr_ + ZC_RQ); rk[k_] = *(const v4u*)(zr_ + ZC_RK); } \
        rv = *(const v4u*)(Z + (size_t)(r0_ + vrow) * ZLD + ZC_RV + h * 128 + dvq * 32 + vc4 * 8); } while (0)
#define RET_STORE() do { \
        _Pragma("unroll") for (int k_ = 0; k_ < 2; ++k_) { const int row_ = qrow0 + 64 * k_; const int e_ = dir ? 127 - row_ : row_; const float kd_ = 0.125f * __builtin_amdgcn_exp2f((float)(127 - e_) * lg2); \
            *(LAS v4u*)(lds + OFF_Q + row_ * QS + qc8 * 16) = rq[k_]; \
            const unsigned kw_[4] = {rk[k_].x, rk[k_].y, rk[k_].z, rk[k_].w}; v4u ks_; unsigned* ksp_ = (unsigned*)&ks_; \
            _Pragma("unroll") for (int q_ = 0; q_ < 4; ++q_) { const float lo_ = bflo(kw_[q_]), hi_ = bfhi(kw_[q_]); ksp_[q_] = pk2(lo_ * 0.125f, hi_ * 0.125f); \
                *(LAS bf16_t*)(lds + OFF_KT + (qc8 * 8 + 2 * q_) * TS + row_ * 2) = (bf16_t)f2bf(lo_ * kd_); *(LAS bf16_t*)(lds + OFF_KT + (qc8 * 8 + 2 * q_ + 1) * TS + row_ * 2) = (bf16_t)f2bf(hi_ * kd_); } \
            *(LAS v4u*)(lds + OFF_K + row_ * QS + qc8 * 16) = ks_; } \
        { const unsigned vw_[4] = {rv.x, rv.y, rv.z, rv.w}; \
          _Pragma("unroll") for (int q_ = 0; q_ < 4; ++q_) { *(LAS bf16_t*)(lds + OFF_VT + (vc4 * 8 + 2 * q_) * TS + vrow * 2) = (bf16_t)(vw_[q_] & 0xffffu); *(LAS bf16_t*)(lds + OFF_VT + (vc4 * 8 + 2 * q_ + 1) * TS + vrow * 2) = (bf16_t)(vw_[q_] >> 16); } } } while (0)
    __syncthreads();
    RET_LOAD(0); RET_STORE();
    { unsigned z0; asm volatile("v_mov_b32 %0, 0" : "=v"(z0));
      if (tid < 288) *(LAS unsigned*)(lds + OFF_ST + tid * 16) = z0, *(LAS unsigned*)(lds + OFF_ST + tid * 16 + 4) = z0, *(LAS unsigned*)(lds + OFF_ST + tid * 16 + 8) = z0, *(LAS unsigned*)(lds + OFF_ST + tid * 16 + 12) = z0; }
    __syncthreads();
    for (int p = 0; p < 18; ++p) {
        if (p + 1 < 18) RET_LOAD(p + 1);
        const bool want_out = (p >= 2) || (l == 0);
        if (want_out) {
            bf16x8 qf[2];
#pragma unroll
            for (int ks = 0; ks < 2; ++ks) qf[ks] = ldsv(lds + OFF_Q + (16 * w + lr) * QS + ks * 64 + g * 16);
            const int i = 16 * w + lr, ei = dir ? 127 - i : i;
#pragma unroll
            for (int ct = 0; ct < 8; ++ct) {
                f32x4 a = {0.f, 0.f, 0.f, 0.f};
#pragma unroll
                for (int ks = 0; ks < 2; ++ks) a = __builtin_amdgcn_mfma_f32_16x16x32_bf16(ldsv(lds + OFF_K + (16 * ct + lr) * QS + ks * 64 + g * 16), qf[ks], a, 0, 0, 0);
                float m[4];
#pragma unroll
                for (int r = 0; r < 4; ++r) { const int j = 16 * ct + 4 * g + r, ej = dir ? 127 - j : j; m[r] = ei >= ej ? a[r] * __builtin_amdgcn_exp2f((float)(ei - ej) * lg2) : 0.f; }
                v2u wv; wv.x = pk2(m[0], m[1]); wv.y = pk2(m[2], m[3]);
                *(LAS v2u*)(lds + OFF_A + i * TS + (16 * ct + 4 * g) * 2) = wv;
            }
            f32x4 oc[2];
#pragma unroll
            for (int nt = 0; nt < 2; ++nt) { oc[nt] = (f32x4){0.f, 0.f, 0.f, 0.f};
#pragma unroll
                for (int ks = 0; ks < 2; ++ks) oc[nt] = __builtin_amdgcn_mfma_f32_16x16x32_bf16(qf[ks], ldsv(lds + OFF_ST + (16 * nt + lr) * QS + ks * 64 + g * 16), oc[nt], 0, 0, 0); }
#pragma unroll
            for (int r = 0; r < 4; ++r) { const int i2 = 16 * w + 4 * g + r, e2 = dir ? 127 - i2 : i2; const float qd = __builtin_amdgcn_exp2f((float)(e2 + 1) * lg2); oc[0][r] *= qd; oc[1][r] *= qd; }
            LDS_WAIT(); asm volatile("" ::: "memory");
#pragma unroll
            for (int ks = 0; ks < 4; ++ks) { const bf16x8 af = ldsv(lds + OFF_A + (16 * w + lr) * TS + ks * 64 + g * 16);
#pragma unroll
                for (int nt = 0; nt < 2; ++nt) oc[nt] = __builtin_amdgcn_mfma_f32_16x16x32_bf16(af, ldsv(lds + OFF_VT + (16 * nt + lr) * TS + ks * 64 + g * 16), oc[nt], 0, 0, 0); }
            bf16_t* ro = WSP(bf16_t, WS_RO) + (size_t)dir * TT * 512 + (size_t)(RET_ROW0(p) + 16 * w + 4 * g) * 512 + h * 128 + dvq * 32 + ((lr & 1) ? 16 + lr - 1 : lr);
#pragma unroll
            for (int r = 0; r < 4; ++r) { const float got = sx<1>((lr & 1) ? oc[0][r] : oc[1][r]);
                *(unsigned*)(ro + r * 512) = (lr & 1) ? pk2(got, oc[1][r]) : pk2(oc[0][r], got); }
        }
        S = S * cd;
#pragma unroll
        for (int ks = 0; ks < 4; ++ks) S = __builtin_amdgcn_mfma_f32_16x16x32_bf16(ldsv(lds + OFF_KT + (16 * (w >> 1) + lr) * TS + ks * 64 + g * 16), ldsv(lds + OFF_VT + (16 * (w & 1) + lr) * TS + ks * 64 + g * 16), S, 0, 0, 0);
        __syncthreads();
        { v2u sv; sv.x = pk2(S[0], S[1]); sv.y = pk2(S[2], S[3]); *(LAS v2u*)(lds + OFF_ST + (16 * (w & 1) + lr) * QS + (16 * (w >> 1) + 4 * g) * 2) = sv; }
        if (p + 1 < 18) RET_STORE();
        __syncthreads();
    }
#undef RET_ROW0
#undef RET_LOAD
#undef RET_STORE
}
}

__device__ __forceinline__ void ret_phase(const Frame& F, int l) {
    for (int item = F.bid; item < 256; item += F.G) { const int dvq = item & 3, dir = (item >> 2) & 1, h = (item >> 3) & 3, b = item >> 5; ret::ret_item(F, l, b, h, dir, dvq); }
    __syncthreads();
}

namespace hy {
#define HY_LDS LAS
#define HY_FN __device__ __forceinline__
#define HY_CPX_VEC 1
#ifdef HY_CPX_VEC
typedef float cpx __attribute__((ext_vector_type(2)));
#else
struct cpx { float x, y; };
#endif
HY_FN cpx cmul(cpx a, cpx b) { cpx r; r.x = a.x * b.x - a.y * b.y; r.y = a.x * b.y + a.y * b.x; return r; }
HY_FN cpx cadd(cpx a, cpx b) { cpx r; r.x = a.x + b.x; r.y = a.y + b.y; return r; }
HY_FN cpx csub(cpx a, cpx b) { cpx r; r.x = a.x - b.x; r.y = a.y - b.y; return r; }
HY_FN cpx cmuli_neg(cpx a) { cpx r; r.x = a.y; r.y = -a.x; return r; }
HY_FN void dft8(cpx (&v)[8]) {
    const float R = 0.70710678118654752f;
    cpx a0 = cadd(v[0], v[4]), a1 = cadd(v[1], v[5]), a2 = cadd(v[2], v[6]), a3 = cadd(v[3], v[7]);
    cpx b0 = csub(v[0], v[4]), b1 = csub(v[1], v[5]), b2 = csub(v[2], v[6]), b3 = csub(v[3], v[7]);
    { cpx t; t.x = (b1.x + b1.y) * R; t.y = (b1.y - b1.x) * R; b1 = t; }
    b2 = cmuli_neg(b2);
    { cpx t; t.x = (b3.y - b3.x) * R; t.y = -(b3.x + b3.y) * R; b3 = t; }
    { cpx s0 = cadd(a0, a2), s1 = csub(a0, a2), s2 = cadd(a1, a3), s3 = cmuli_neg(csub(a1, a3));
      v[0] = cadd(s0, s2); v[2] = cadd(s1, s3); v[4] = csub(s0, s2); v[6] = csub(s1, s3); }
    { cpx s0 = cadd(b0, b2), s1 = csub(b0, b2), s2 = cadd(b1, b3), s3 = cmuli_neg(csub(b1, b3));
      v[1] = cadd(s0, s2); v[3] = cadd(s1, s3); v[5] = csub(s0, s2); v[7] = csub(s1, s3); }
}
HY_FN cpx hlook(const HY_LDS cpx* Hh, int f) { if (f <= 2048) return Hh[f]; cpx h = Hh[4096 - f]; h.y = -h.y; return h; }
HY_FN int hpad(int i) { return i + (i >> 3); }
template <bool MULH> HY_FN void fft_pass_read(const HY_LDS cpx* X, const HY_LDS cpx* TW, const HY_LDS cpx* Hh, int j, int Ns, cpx (&v)[8]) {
#pragma unroll
    for (int t = 0; t < 8; ++t) { v[t] = X[hpad(j + 512 * t)]; if (MULH) { cpx r = cmul(v[t], hlook(Hh, j + 512 * t)); r.y = -r.y; v[t] = r; } }
    if (Ns > 1) {
        const int k = j & (Ns - 1);
        const cpx w1 = TW[k * (512 / Ns)];
        const cpx w2 = cmul(w1, w1), w3 = cmul(w2, w1), w4 = cmul(w2, w2), w5 = cmul(w4, w1), w6 = cmul(w3, w3), w7 = cmul(w4, w3);
        v[1] = cmul(v[1], w1); v[2] = cmul(v[2], w2); v[3] = cmul(v[3], w3); v[4] = cmul(v[4], w4); v[5] = cmul(v[5], w5); v[6] = cmul(v[6], w6); v[7] = cmul(v[7], w7);
    }
    dft8(v);
}
HY_FN void fft_pass_write(HY_LDS cpx* X, int j, int Ns, const cpx (&v)[8]) {
    const int k = j & (Ns - 1), j0 = ((j - k) << 3) + k;
#pragma unroll
    for (int u = 0; u < 8; ++u) X[hpad(j0 + u * Ns)] = v[u];
}

#undef HY_LDS
#undef HY_FN
constexpr int XBYTES = 4608 * 8;
constexpr int OFF_XA = 0, OFF_XB = XBYTES, OFF_H0 = 2 * XBYTES, OFF_H1 = OFF_H0 + 16400, OFF_TW = OFF_H1 + 16400, HY_LDS_BYTES = OFF_TW + 4096;
static_assert(HY_LDS_BYTES <= RING_BYTES, "hyena LDS");
template <bool MULH> __device__ __forceinline__ void fft4096(LAS cpx* A, LAS cpx* B, const LAS cpx* TW, const LAS cpx* Hh, int j) {
    cpx v[8];
    fft_pass_read<MULH>(A, TW, Hh, j, 1, v); fft_pass_write(B, j, 1, v); __syncthreads();
    fft_pass_read<false>(B, TW, Hh, j, 8, v); fft_pass_write(A, j, 8, v); __syncthreads();
    fft_pass_read<false>(A, TW, Hh, j, 64, v); fft_pass_write(B, j, 64, v); __syncthreads();
    fft_pass_read<false>(B, TW, Hh, j, 512, v); fft_pass_write(A, j, 512, v); __syncthreads();
}
struct SRaw { v2u w; bf16_t m, p; };
__device__ __forceinline__ SRaw sraw_load(const bf16_t* rp, int t0) { SRaw r; r.w = *(const v2u*)(rp + t0); r.m = t0 > 0 ? rp[t0 - 1] : (bf16_t)0; r.p = t0 + 4 < SEQ ? rp[t0 + 4] : (bf16_t)0; return r; }
__device__ __forceinline__ void sconv_apply(const SRaw& r, float w0, float w1, float w2, float bias, float (&o)[4]) {
    const float u0 = bflo(r.w.x), u1 = bfhi(r.w.x), u2 = bflo(r.w.y), u3 = bfhi(r.w.y), um = bf1(r.m), up = bf1(r.p);
    o[0] = w0 * um + w1 * u0 + w2 * u1 + bias; o[1] = w0 * u0 + w1 * u1 + w2 * u2 + bias; o[2] = w0 * u1 + w1 * u2 + w2 * u3 + bias; o[3] = w0 * u2 + w1 * u3 + w2 * up + bias;
}
__device__ __forceinline__ void hy_item(const Frame& F, int l, int c) {
    LAS char* lds = (LAS char*)F.lds;
    int tid = F.tid; asm volatile("" : "+v"(tid));
    LAS cpx* XA = (LAS cpx*)(lds + OFF_XA); LAS cpx* XB = (LAS cpx*)(lds + OFF_XB); LAS cpx* H0 = (LAS cpx*)(lds + OFF_H0); LAS cpx* H1 = (LAS cpx*)(lds + OFF_H1); LAS cpx* TW = (LAS cpx*)(lds + OFF_TW);
    const bf16_t* ZT = WSP(bf16_t, WS_ZT);
    const float* cw = F.in[IN_HCW] + (size_t)l * 3 * 1536; const float* cb = F.in[IN_HCB] + (size_t)l * 1536; const float* skip = F.in[IN_HSKIP] + (size_t)l * 2 * 512;
    __syncthreads();
    { float sn, cs; sincosf(6.2831853071795864f * (float)tid * (1.0f / 4096.0f), &sn, &cs); cpx t; t.x = cs; t.y = -sn; TW[tid] = t; }
    {
        const float* t0p = WSP(float, WS_TAPS) + (((size_t)l * 2 + 0) * 512 + c) * 4096 + 8 * tid; const float* t1p = t0p + (size_t)512 * 4096;
        const f32x4 a0 = *(const f32x4*)t0p, a1 = *((const f32x4*)t0p + 1), b0 = *(const f32x4*)t1p, b1 = *((const f32x4*)t1p + 1);
#pragma unroll
        for (int i = 0; i < 4; ++i) { cpx z; z.x = a0[i]; z.y = b0[i]; XA[9 * tid + i] = z; z.x = a1[i]; z.y = b1[i]; XA[9 * tid + 4 + i] = z; }
    }
    __syncthreads();
    fft4096<false>(XA, XB, TW, H0, tid);
    { const float sk0 = skip[c], sk1 = skip[512 + c], sc = 1.0f / 4096.0f;
      for (int f = tid; f <= 2048; f += NTHR) { const cpx zf = XA[hpad(f)], zn = XA[hpad((4096 - f) & 4095)]; cpx h;
          h.x = (0.5f * (zf.x + zn.x) + sk0) * sc; h.y = 0.5f * (zf.y - zn.y) * sc; H0[f] = h;
          h.x = (0.5f * (zf.y + zn.y) + sk1) * sc; h.y = -0.5f * (zf.x - zn.x) * sc; H1[f] = h; } }
    const int t0 = 4 * tid, p0 = t0 + (t0 >> 3), p1 = p0 + 2304;
    const float wx1[4] = {cw[c], cw[1536 + c], cw[3072 + c], cb[c]}, wx2[4] = {cw[512 + c], cw[1536 + 512 + c], cw[3072 + 512 + c], cb[512 + c]}, wv[4] = {cw[1024 + c], cw[1536 + 1024 + c], cw[3072 + 1024 + c], cb[1024 + c]};
    SRaw nva = sraw_load(ZT + (size_t)(1024 + c) * TT, t0), nvb = sraw_load(ZT + (size_t)(1024 + c) * TT + SEQ, t0);
    for (int q = 0; q < 4; ++q) {
        __syncthreads();
        const SRaw g1a = sraw_load(ZT + (size_t)c * TT + (2 * q) * SEQ, t0), g1b = sraw_load(ZT + (size_t)c * TT + (2 * q + 1) * SEQ, t0);
        const SRaw g2a = sraw_load(ZT + (size_t)(512 + c) * TT + (2 * q) * SEQ, t0), g2b = sraw_load(ZT + (size_t)(512 + c) * TT + (2 * q + 1) * SEQ, t0);
        float va[4], vb[4];
        sconv_apply(nva, wv[0], wv[1], wv[2], wv[3], va); sconv_apply(nvb, wv[0], wv[1], wv[2], wv[3], vb);
#pragma unroll
        for (int i = 0; i < 4; ++i) { cpx z; z.x = va[i]; z.y = vb[i]; XA[p0 + i] = z; z.x = 0.f; z.y = 0.f; XA[p1 + i] = z; }
        __syncthreads();
        fft4096<false>(XA, XB, TW, H0, tid); fft4096<true>(XA, XB, TW, H0, tid);
        {
            float ga[4], gb[4];
            sconv_apply(g1a, wx1[0], wx1[1], wx1[2], wx1[3], ga); sconv_apply(g1b, wx1[0], wx1[1], wx1[2], wx1[3], gb);
#pragma unroll
            for (int i = 0; i < 4; ++i) { const cpx y = XA[p0 + i]; cpx z; z.x = ga[i] * y.x; z.y = gb[i] * (-y.y); XA[p0 + i] = z; z.x = 0.f; z.y = 0.f; XA[p1 + i] = z; }
            const int qn = q < 3 ? q + 1 : q;
            nva = sraw_load(ZT + (size_t)(1024 + c) * TT + (2 * qn) * SEQ, t0); nvb = sraw_load(ZT + (size_t)(1024 + c) * TT + (2 * qn + 1) * SEQ, t0);
        }
        __syncthreads();
        fft4096<false>(XA, XB, TW, H1, tid); fft4096<true>(XA, XB, TW, H1, tid);
        {   float ga[4], gb[4];
            sconv_apply(g2a, wx2[0], wx2[1], wx2[2], wx2[3], ga); sconv_apply(g2b, wx2[0], wx2[1], wx2[2], wx2[3], gb);
            f32x4 oa, ob;
#pragma unroll
            for (int i = 0; i < 4; ++i) { const cpx y = XA[p0 + i]; oa[i] = ga[i] * y.x; ob[i] = gb[i] * (-y.y); }
            bf16_t* hp = WSP(bf16_t, WS_HY) + (size_t)c * TT + (2 * q) * SEQ + t0;
            v2u wa, wb; wa.x = pk2(oa[0], oa[1]); wa.y = pk2(oa[2], oa[3]); wb.x = pk2(ob[0], ob[1]); wb.y = pk2(ob[2], ob[3]);
            *(v2u*)hp = wa; *(v2u*)(hp + SEQ) = wb;
        }
    }
    __syncthreads();
}
}

__device__ __forceinline__ void hyena_phase(const Frame& F, int l) {
    for (int c = F.bid; c < 512; c += F.G) hy::hy_item(F, l, c);
    __syncthreads();
}

#ifndef WGM_DEFAULT
#define WGM_DEFAULT 4
#endif
#ifndef WGM_GU
#define WGM_GU 4
#endif
#define PG8_ALIGN true
#define PG8_SP2 true
__device__ __forceinline__ bool rebase(Frame& F, const Args& args) {
    size_t zz = 0; asm volatile("s_mov_b64 %0, 0" : "=s"(zz)); F.in = args.in + zz; F.ws = args.ws + zz; F.out = args.out + zz;
    int wv = F.wave0; asm volatile("" : "+s"(wv));
    int ln; asm volatile("v_mbcnt_lo_u32_b32 %0, -1, 0\n\tv_mbcnt_hi_u32_b32 %0, -1, %0" : "=v"(ln)); int t = wv * 64 + ln; int g = gridDim.x, b = blockIdx.x; asm volatile("" : "+s"(g), "+s"(b));
    F.tid = t; F.lane = t & 63; F.wave = __builtin_amdgcn_readfirstlane(t >> 6); F.G = g; F.bid = b; F.gw = b * NWAVES + F.wave; F.NGW = g * NWAVES;
    return true;
}
template <class Epi>
__device__ __forceinline__ void run_gemm(const Frame& F, const bf16_t* A, const bf16_t* Bt, int M, int N, int K, const Epi& E, int wgm = WGM_DEFAULT, bool rev = false) {
    pg8::Gemm g{A, Bt, M, N, K, K}; pg8::StaticOrder S; S.init(M, N, F.G, rev ? F.G - 1 - F.bid : F.bid, wgm);
    pg8::gemm_phase<Epi, pg8::StaticOrder, PG8_ALIGN, PG8_SP2>(F.lds, g, S, E, F.tid);
}

__device__ __forceinline__ void run_down(const Frame& F, const bf16_t* Gbuf, const bf16_t* Wd, const float* resx, float* outx, const float* gate) {
    { pg8::EpiResid E{resx, resx, outx, outx, gate, 0.5f}; run_gemm(F, Gbuf, Wd, TX, DM, FF, E); }
    { pg8::Gemm g{Gbuf + (size_t)TX * FF, Wd, TC, DM, FF / 4, FF}; pg8::SplitKOrder S{F.G, F.bid, 4, FF / 4}; pg8::EpiPartial E{WSP(float, WS_PART), (FF / 4) * 2};
      pg8::gemm_phase<pg8::EpiPartial, pg8::SplitKOrder, PG8_ALIGN, PG8_SP2>(F.lds, g, S, E, F.tid); }
}

__device__ __forceinline__ void tail_taps(const Frame& F, int sel, int nunits) {
    const int rem = nunits % F.G, sb = rem ? F.bid - rem : F.bid, sg = rem ? F.G - rem : F.G;
    __syncthreads();
    if (sb >= 0) p1_taps(F, sel, sb * NWAVES + F.wave, sg * NWAVES);
}

__global__ void __launch_bounds__(NTHR, 2) fwd_kernel(Args args) {
    extern __shared__ __attribute__((aligned(16))) unsigned char lds_raw[];
    Frame F;
    F.lds = (LAS unsigned char*)lds_raw;
    F.tid = threadIdx.x; F.lane = F.tid & 63; F.wave = __builtin_amdgcn_readfirstlane(F.tid >> 6); F.wave0 = F.wave;
    F.G = gridDim.x; F.bid = blockIdx.x; F.gw = blockIdx.x * NWAVES + F.wave; F.NGW = F.G * NWAVES;
    F.in = args.in; F.ws = args.ws; F.out = args.out;
    volatile LAS unsigned* MISC = (volatile LAS unsigned*)(F.lds + MISC_OFF);
    for (int u = F.tid; u < (LDS_BYTES - LDSCTL_OFF) / 4; u += NTHR) ((LAS unsigned*)(F.lds + LDSCTL_OFF))[u] = 0u;
    __syncthreads();
    const int lo = args.ph_lo, hi = args.ph_hi;
    const bool multi = (hi - lo) > 1; const int bsel = args.bar_sel;
    XcdBarrier bar; bar.bar = (unsigned*)(F.ws + WS_CTL) + CW_BAR + args.bar_sel * XCD_BAR_WORDS; bar.x = 0; bar.st = nullptr;
    if (multi) bar = xcd_barrier_post((unsigned*)(F.ws + WS_CTL) + CW_BAR + args.bar_sel * XCD_BAR_WORDS, MISC + 8, F.tid);
#ifdef STAMPS
#define STAMP(k) (((F.bid == 0 && F.tid == 0) ? (void)(((unsigned long long*)(F.ws + WS_END))[(k)] = __builtin_amdgcn_s_memrealtime()) : (void)0), true)
#else
#define STAMP(k) true
#endif
#define IN(k) (lo <= (k) && (k) < hi && rebase(F, args) && STAMP(k))
#define SEAM(k) do { if (lo <= (k) && (k) + 1 < hi && rebase(F, args)) { XcdBarrier b_ = bar; b_.bar = (unsigned*)(F.ws + WS_CTL) + CW_BAR + bsel * XCD_BAR_WORDS; xcd_barrier(b_, F.tid); } } while (0)

    if (IN(0)) { p0_modpart(F); rebase(F, args); p0_hyh2(F); rebase(F, args); p0_weights(F); } SEAM(0);

    for (int l = 0; l < 2; ++l) {
        const int pb = 2 + l * NPH_L;
#define wl (F.ws + WS_W + (size_t)l * LW)
#define modl (WSP(float, WS_MOD) + (size_t)l * 9 * NMODC)
#define xres WSP(float, WS_XRES)
#define xresc (WSP(float, WS_XRES) + (size_t)TX * DM)
#define srcx (l == 0 ? F.in[IN_X] : (const float*)xres)
#define srcc (l == 0 ? F.in[IN_CTX] : (const float*)xresc)
        const int Mmix = (l == 0) ? TT : TX;

        if (IN(pb + 0)) { norm_phase(F, srcx, srcc, TT, modl, 0, 1, WSP(bf16_t, WS_HMOD), l == 0 ? nullptr : WSP(float, WS_PART), WSP(float, WS_MOD) + 8 * NMODC + 8 * DM, xresc); }
        SEAM(pb + 0);
        if (IN(pb + 1)) { { pg8::EpiSwiGLU E{WSP(bf16_t, WS_G), FF}; run_gemm(F, WSP(bf16_t, WS_HMOD), (const bf16_t*)(wl + LW_GU1), TT, 2 * FF, DM, E, WGM_GU); } if (l == 0) tail_taps(F, 0, (TT / 256) * (2 * FF / 256)); }
        SEAM(pb + 1);
        if (IN(pb + 2)) run_down(F, WSP(bf16_t, WS_G), (const bf16_t*)(wl + LW_D1), srcx, xres, modl + 2 * DM);
        SEAM(pb + 2);
        if (IN(pb + 3)) norm_phase(F, xres, srcc, TT, modl, 3, 4, WSP(bf16_t, WS_HMOD), WSP(float, WS_PART), modl + 8 * NMODC + 2 * DM, xresc);
        SEAM(pb + 3);
        if (IN(pb + 4)) {
            { pg8::EpiBf16 E{WSP(bf16_t, WS_Z), ZLD}; run_gemm(F, WSP(bf16_t, WS_HMOD), (const bf16_t*)(wl + LW_WINM), TT, ZLD, DM, E); }
            { pg8::EpiBf16 E{WSP(bf16_t, WS_ZT), TT}; run_gemm(F, (const bf16_t*)(wl + LW_WINH), WSP(bf16_t, WS_HMOD), 1536, TT, DM, E); }
        }
        SEAM(pb + 4);
        if (IN(pb + 5)) postproj_phase(F, l);
        SEAM(pb + 5);
        if (IN(pb + 6)) {
            { pg8::EpiBf16 E{WSP(bf16_t, WS_KV), 2048}; run_gemm(F, WSP(bf16_t, WS_KVN), (const bf16_t*)(wl + LW_WUKV), TT, 2048, 256, E); }
            { pg8::EpiBf16 E{WSP(bf16_t, WS_Q), 1536}; run_gemm(F, WSP(bf16_t, WS_QN), (const bf16_t*)(wl + LW_WUQ), Mmix, 1536, 512, E, WGM_DEFAULT, true); }
        }
        SEAM(pb + 6);
        if (IN(pb + 7)) headnorm_phase(F, l);
        SEAM(pb + 7);
        if (IN(pb + 8)) { const int mm = args.pad; if (mm & 1) attn_phase(F, l); rebase(F, args); (void)STAMP(32 + 4 * l); if (mm & 2) ret_phase(F, l); rebase(F, args); (void)STAMP(33 + 4 * l); if (mm & 4) hyena_phase(F, l); rebase(F, args); (void)STAMP(34 + 4 * l); if (mm & 8) hyena_ctx(F, l); }
        SEAM(pb + 8);
        if (IN(pb + 9)) merge_phase(F, l);
        SEAM(pb + 9);
        if (IN(pb + 10)) {
            { pg8::EpiResid E{xres, xresc, xres, xresc, modl + 5 * DM, 1.0f}; run_gemm(F, WSP(bf16_t, WS_HMOD), (const bf16_t*)(wl + LW_WOUT), TX, DM, DM, E); }
            if (l == 0) { pg8::Gemm g{WSP(bf16_t, WS_HMOD) + (size_t)TX * DM, (const bf16_t*)(wl + LW_WOUT), TC, DM, DM / 4, DM}; pg8::SplitKOrder S{F.G, F.bid, 4, DM / 4}; pg8::EpiPartial E{WSP(float, WS_PART), (DM / 4) * 2};
                pg8::gemm_phase<pg8::EpiPartial, pg8::SplitKOrder, PG8_ALIGN, PG8_SP2>(F.lds, g, S, E, F.tid); }
        }
        SEAM(pb + 10);
        if (IN(pb + 11)) norm_phase(F, xres, xresc, Mmix, modl, 6, 7, WSP(bf16_t, WS_HMOD), l == 0 ? WSP(float, WS_PART) : nullptr, modl + 8 * NMODC + 5 * DM, xresc, 1.0f);
        SEAM(pb + 11);
        if (IN(pb + 12)) { { pg8::EpiSwiGLU E{WSP(bf16_t, WS_G), FF}; run_gemm(F, WSP(bf16_t, WS_HMOD), (const bf16_t*)(wl + LW_GU2), Mmix, 2 * FF, DM, E, WGM_GU); } if (l == 0) tail_taps(F, 1, (TT / 256) * (2 * FF / 256)); }
        SEAM(pb + 12);
        if (IN(pb + 13)) { if (l == 0) run_down(F, WSP(bf16_t, WS_G), (const bf16_t*)(wl + LW_D2), xres, xres, modl + 8 * DM);
            else { pg8::EpiResid E{xres, xresc, F.out, xresc, modl + 8 * DM, 0.5f}; run_gemm(F, WSP(bf16_t, WS_G), (const bf16_t*)(wl + LW_D2), TX, DM, FF, E); } }
        if (l == 0) SEAM(pb + 13);
    }
    if (hi == NPH) { rebase(F, args); (void)STAMP(NPH); }
#undef IN
#undef SEAM
#undef wl
#undef modl
#undef xres
#undef xresc
#undef srcx
#undef srcc
}

#ifdef STAMPS
__global__ void spin_kernel(const unsigned long long* ts, int k0, int k1, int factor) {
    if (threadIdx.x == 0) { const unsigned long long d = (ts[k1] - ts[k0]) * (unsigned long long)factor, t0 = __builtin_amdgcn_s_memrealtime();
        while (__builtin_amdgcn_s_memrealtime() - t0 < d) __builtin_amdgcn_s_sleep(16); }
}
#endif
#ifndef MK_ONE_LAUNCH
#define MK_ONE_LAUNCH 1
#endif
extern "C" void kernel_launch(void* const* d_in, const int* in_sizes, int n_in, void* d_out, int out_size, void* d_ws, size_t ws_size, hipStream_t stream) {
    static int grid = 0;
    if (grid == 0) {
        if (n_in != N_IN || out_size != TX * DM || ws_size < WS_END + 4096) { fprintf(stderr, "kernel_launch: unexpected shapes (n_in %d, out %d, ws %zu < %zu)\n", n_in, out_size, ws_size, (size_t)WS_END); grid = -1; return; }
        int dev = 0, cus = 0, per_cu = 0;
        if (hipGetDevice(&dev) != hipSuccess || hipDeviceGetAttribute(&cus, hipDeviceAttributeMultiprocessorCount, dev) != hipSuccess) { grid = -1; return; }
        if (hipFuncSetAttribute((const void*)fwd_kernel, hipFuncAttributeMaxDynamicSharedMemorySize, LDS_BYTES) != hipSuccess) { fprintf(stderr, "kernel_launch: hipFuncSetAttribute failed\n"); grid = -1; return; }
        if (hipOccupancyMaxActiveBlocksPerMultiprocessor(&per_cu, (const void*)fwd_kernel, NTHR, LDS_BYTES) != hipSuccess || per_cu < 1) { fprintf(stderr, "kernel_launch: occupancy query reports %d blocks per CU\n", per_cu); }
        (void)hipGetLastError();
        grid = cus;
    }
    if (grid < 0) return;
    (void)hipMemsetAsync((char*)d_ws + WS_CTL, 0, CTL_BYTES + (size_t)2 * 9 * NMODC * 4, stream);
    Args a{};
    for (int i = 0; i < N_IN; ++i) a.in[i] = (const float*)d_in[i];
    a.out = (float*)d_out; a.ws = (unsigned char*)d_ws; a.pad = 15;
#if MK_ONE_LAUNCH
    a.ph_lo = 0; a.ph_hi = NPH;
    hipLaunchKernelGGL(fwd_kernel, dim3(grid), dim3(NTHR), LDS_BYTES, stream, a);
#ifdef STAMPS
    hipLaunchKernelGGL(spin_kernel, dim3(1), dim3(64), 0, stream, (const unsigned long long*)((const char*)d_ws + WS_END), PROBE_K0, PROBE_K1, PROBE_F);
#endif
#ifdef PROBE_LO
    a.ph_lo = PROBE_LO; a.ph_hi = PROBE_HI; a.bar_sel = 1;
#ifdef PROBE_MASK
    a.pad = PROBE_MASK;
#endif
    hipLaunchKernelGGL(fwd_kernel, dim3(grid), dim3(NTHR), LDS_BYTES, stream, a);
#endif
#else
    for (int ph = 0; ph < NPH; ++ph) { a.ph_lo = ph; a.ph_hi = ph + 1; hipLaunchKernelGGL(fwd_kernel, dim3(grid), dim3(NTHR), LDS_BYTES, stream, a); }
#endif
}
```
